# Optimizing an MI355X kernel written in HIP

```python
import jax, jax.numpy as jnp
from jax import lax
import numpy as np

D_MODEL = 2048
BATCH = 4
SEQ = 2048
DEPTH = 1

N_HEADS = 16
QK_NOPE_DIM = 128
QK_ROPE_DIM = 64
V_HEAD_DIM = 128
Q_LORA_RANK = 512
KV_LORA_RANK = 512
ROPE_THETA = 10000.0
Q_BLOCK = 128

SGU_GROUPS = 8
SGU_GROUP_DIM = 128
SGU_WIDTH = SGU_GROUPS * SGU_GROUP_DIM
CHUNK = 128

D_FF = -(-8 * D_MODEL // (3 * 256)) * 256

N_BRANCH = 2
RMS_EPS = 1e-6

D_IN = Q_LORA_RANK + KV_LORA_RANK + QK_ROPE_DIM + 2 * SGU_WIDTH + N_BRANCH * D_MODEL

kernel_name = "hybrid_mla_sgu_gated_block"


def rms_norm(x, g):
    xf = x.astype(jnp.float32)
    y = xf * lax.rsqrt(jnp.mean(xf * xf, axis=-1, keepdims=True) + RMS_EPS)
    return (y * g.astype(jnp.float32)).astype(x.dtype)


def rope_tables(positions):
    inv_freq = ROPE_THETA ** (-jnp.arange(0, QK_ROPE_DIM, 2, dtype=jnp.float32) / QK_ROPE_DIM)
    ang = positions.astype(jnp.float32)[..., None] * inv_freq
    return jnp.cos(ang), jnp.sin(ang)


def apply_rope(x, cos, sin):
    xf = x.astype(jnp.float32)
    x1, x2 = jnp.split(xf, 2, axis=-1)
    return jnp.concatenate([x1 * cos - x2 * sin, x2 * cos + x1 * sin], axis=-1).astype(x.dtype)


def mla(q_lat, kv_lat, k_pe, cos, sin, q_norm_g, w_uq, kv_norm_g, w_ukv):
    B, S, _ = q_lat.shape
    q = (rms_norm(q_lat, q_norm_g) @ w_uq).reshape(B, S, N_HEADS, QK_NOPE_DIM + QK_ROPE_DIM)
    q_nope = q[..., :QK_NOPE_DIM]
    q_pe = apply_rope(q[..., QK_NOPE_DIM:], cos[:, :, None, :], sin[:, :, None, :])
    kv = (rms_norm(kv_lat, kv_norm_g) @ w_ukv).reshape(B, S, N_HEADS, QK_NOPE_DIM + V_HEAD_DIM)
    k_nope = kv[..., :QK_NOPE_DIM]
    v = kv[..., QK_NOPE_DIM:]
    k_pe = apply_rope(k_pe, cos, sin)
    scale = (QK_NOPE_DIM + QK_ROPE_DIM) ** -0.5
    outs = []
    for i in range(S // Q_BLOCK):
        q0 = i * Q_BLOCK
        k_end = q0 + Q_BLOCK
        s = (jnp.einsum('bqhd,bkhd->bhqk', q_nope[:, q0:k_end], k_nope[:, :k_end])
             + jnp.einsum('bqhd,bkd->bhqk', q_pe[:, q0:k_end], k_pe[:, :k_end]))
        s = s.astype(jnp.float32) * scale
        causal = (q0 + jnp.arange(Q_BLOCK))[:, None] >= jnp.arange(k_end)[None, :]
        s = jnp.where(causal, s, jnp.finfo(jnp.float32).min)
        p = jax.nn.softmax(s, axis=-1).astype(v.dtype)
        outs.append(jnp.einsum('bhqk,bkhd->bqhd', p, v[:, :k_end]))
    return jnp.concatenate(outs, axis=1).reshape(B, S, N_HEADS * V_HEAD_DIM)


def sgu(uv, norm_g, w_s, b_s):
    B, S, _ = uv.shape
    uv = jax.nn.gelu(uv)
    u, v = uv[..., :SGU_WIDTH], uv[..., SGU_WIDTH:]
    v = rms_norm(v, norm_g).reshape(B, S // CHUNK, CHUNK, SGU_GROUPS, SGU_GROUP_DIM)
    tril = jnp.tril(jnp.ones((CHUNK, CHUNK), dtype=bool))
    ws = jnp.where(tril[None], w_s, jnp.zeros_like(w_s))
    mixed = jnp.einsum('gts,bnsgd->bntgd', ws, v) + b_s.T[None, None, :, :, None]
    return u * mixed.reshape(B, S, SGU_WIDTH)


def setup_inputs(seed: int = 0) -> dict:
    key = jax.random.key(seed)
    ks = jax.random.split(key, 24)
    f32 = jnp.float32

    def w(k, shape, fan_in):
        return jax.random.normal(k, shape, f32) * fan_in ** -0.5

    def gain(k, shape):
        return 1.0 + 0.01 * jax.random.normal(k, shape, f32)

    L = DEPTH
    x = jax.random.normal(ks[0], (BATCH, SEQ, D_MODEL), f32)
    offsets = jax.random.randint(ks[1], (BATCH, 1), 0, 1024, dtype=jnp.int32)
    positions = (jnp.arange(SEQ, dtype=jnp.int32)[None, :] + offsets).astype(jnp.int32)
    return {
        "x": x,
        "positions": positions,
        "norm_mix_g": gain(ks[2], (L, D_MODEL)),
        "w_in": w(ks[3], (L, D_MODEL, D_IN), D_MODEL),
        "b_gate": 0.01 * jax.random.normal(ks[4], (L, N_BRANCH * D_MODEL), f32),
        "q_norm_g": gain(ks[5], (L, Q_LORA_RANK)),
        "w_uq": w(ks[6], (L, Q_LORA_RANK, N_HEADS * (QK_NOPE_DIM + QK_ROPE_DIM)), Q_LORA_RANK),
        "kv_norm_g": gain(ks[7], (L, KV_LORA_RANK)),
        "w_ukv": w(ks[8], (L, KV_LORA_RANK, N_HEADS * (QK_NOPE_DIM + V_HEAD_DIM)), KV_LORA_RANK),
        "w_o_attn": w(ks[9], (L, N_HEADS * V_HEAD_DIM, D_MODEL), N_HEADS * V_HEAD_DIM),
        "sgu_norm_g": gain(ks[10], (L, SGU_WIDTH)),
        "w_sgu": w(ks[11], (L, SGU_GROUPS, CHUNK, CHUNK), CHUNK),
        "b_sgu": gain(ks[12], (L, SGU_GROUPS, CHUNK)),
        "w_o_sgu": w(ks[13], (L, SGU_WIDTH, D_MODEL), SGU_WIDTH),
        "w_out": w(ks[14], (L, D_MODEL, D_MODEL), D_MODEL),
        "norm_ffn_g": gain(ks[15], (L, D_MODEL)),
        "w_gate_ffn": w(ks[16], (L, D_MODEL, D_FF), D_MODEL),
        "w_up_ffn": w(ks[17], (L, D_MODEL, D_FF), D_MODEL),
        "w_down_ffn": w(ks[18], (L, D_FF, D_MODEL), D_FF),
        "norm_final_g": gain(ks[19], (D_MODEL,)),
    }


def reference(x, positions, norm_mix_g, w_in, b_gate, q_norm_g, w_uq, kv_norm_g, w_ukv, w_o_attn,
              sgu_norm_g, w_sgu, b_sgu, w_o_sgu, w_out, norm_ffn_g, w_gate_ffn, w_up_ffn,
              w_down_ffn, norm_final_g):
    B, S, D = x.shape
    cos, sin = rope_tables(positions)
    o1 = Q_LORA_RANK
    o2 = o1 + KV_LORA_RANK
    o3 = o2 + QK_ROPE_DIM
    o4 = o3 + 2 * SGU_WIDTH
    h = x
    for l in range(DEPTH):
        a = rms_norm(h, norm_mix_g[l])
        z = a @ w_in[l]
        q_lat, kv_lat, k_pe = z[..., :o1], z[..., o1:o2], z[..., o2:o3]
        uv, gate_logits = z[..., o3:o4], z[..., o4:]
        y_attn = mla(q_lat, kv_lat, k_pe, cos, sin, q_norm_g[l], w_uq[l], kv_norm_g[l], w_ukv[l]) @ w_o_attn[l]
        y_sgu = sgu(uv, sgu_norm_g[l], w_sgu[l], b_sgu[l]) @ w_o_sgu[l]
        gates = jax.nn.sigmoid(gate_logits + b_gate[l]).reshape(B, S, N_BRANCH, D)
        merged = gates[:, :, 0, :] * y_attn + gates[:, :, 1, :] * y_sgu
        h = h + merged @ w_out[l]
        f = rms_norm(h, norm_ffn_g[l])
        h = h + (jax.nn.silu(f @ w_gate_ffn[l]) * (f @ w_up_ffn[l])) @ w_down_ffn[l]
    return rms_norm(h, norm_final_g)
```

```cpp
#include <hip/hip_runtime.h>
#include <cstdio>
#include <cstdint>

typedef unsigned short bf16;
constexpr int BATCH = 4, SEQ = 2048, DM = 2048, M = BATCH * SEQ;
constexpr int NH = 16, DNOPE = 128, DROPE = 64, DV = 128, DQK = 192, QLR = 512, KVLR = 512;
constexpr int SGW = 1024, SGG = 8, SGD = 128, CHUNK = 128;
constexpr int DFF = 5632, DIN = 7232;
constexpr int O1 = 512, O2 = 1024, O3 = 1088, O4 = 3136;
constexpr float EPS = 1e-6f;
constexpr float QSCALE = 0.07216878364870322f * 1.4426950408889634f;

constexpr size_t MiB = 1u << 20;
constexpr size_t WS_CTL = 0;
constexpr size_t WS_COS = 1 * MiB, WS_SIN = 2 * MiB;
constexpr size_t WS_RQ = 6 * MiB, WS_RKV = WS_RQ + 32768, WS_RV = WS_RKV + 32768, WS_RF = WS_RV + 32768, WS_RO = WS_RF + 32768;
constexpr size_t WS_XN = 64 * MiB, WS_AO = 64 * MiB;
constexpr size_t WS_U = 96 * MiB, WS_GV = 112 * MiB, WS_YS = 96 * MiB;
constexpr size_t WS_QL = 128 * MiB, WS_KVL = 136 * MiB, WS_KPE = 144 * MiB, WS_SG = 145 * MiB, WS_Q = 161 * MiB, WS_KN = 209 * MiB, WS_V = 241 * MiB;
constexpr size_t WS_MG = 128 * MiB;
constexpr size_t WS_H1 = 161 * MiB, WS_H1B = 225 * MiB;
constexpr size_t WS_ACT = 8 * MiB;
constexpr size_t WS_END = 279 * MiB;

__device__ __forceinline__ float bf2f(bf16 v) { return __uint_as_float((unsigned)v << 16); }
__device__ __forceinline__ bf16 f2bf(float f) { unsigned u = __float_as_uint(f); return (bf16)((u + 0x7fffu + ((u >> 16) & 1u)) >> 16); }
__device__ __forceinline__ float rbf(float f) { return bf2f(f2bf(f)); }
__device__ __forceinline__ float sigmoidf_(float x) { return __builtin_amdgcn_rcpf(1.f + __builtin_amdgcn_exp2f(-x * 1.4426950408889634f)); }
__device__ __forceinline__ float gelu_tanh(float x) { const float y = 0.7978845608028654f * (x + 0.044715f * x * x * x); return x * sigmoidf_(2.f * y); }
__device__ __forceinline__ float wave_sum(float v) {
#pragma unroll
    for (int o = 1; o < 64; o <<= 1) v += __shfl_xor(v, o);
    return v;
}

__global__ void __launch_bounds__(256) k_rope_tab(const int* __restrict__ pos, float* __restrict__ COS, float* __restrict__ SIN) {
    const int idx = blockIdx.x * 256 + threadIdx.x; if (idx >= M * 32) return;
    const int m = idx >> 5, i = idx & 31;
    const float inv = powf(10000.0f, -(float)(2 * i) / 64.0f);
    const float ang = (float)pos[m] * inv;
    COS[idx] = cosf(ang); SIN[idx] = sinf(ang);
}
__global__ void __launch_bounds__(256) k_rmsnorm_x(const float* __restrict__ x, const float* __restrict__ g, bf16* __restrict__ XN) {
    const int lane = threadIdx.x & 63, row = blockIdx.x * 4 + (threadIdx.x >> 6);
    const float* xr = x + (size_t)row * DM; float s = 0.f;
    for (int c = lane; c < DM; c += 64) { const float v = xr[c]; s += v * v; }
    const float r = 1.0f / sqrtf(wave_sum(s) * (1.0f / DM) + EPS);
    for (int c = lane; c < DM; c += 64) XN[(size_t)row * DM + c] = f2bf(xr[c] * r * g[c]);
}
template <class T> __global__ void __launch_bounds__(256) k_rowscale(const T* __restrict__ X, int K, float* __restrict__ r) {
    const int lane = threadIdx.x & 63, row = blockIdx.x * 4 + (threadIdx.x >> 6);
    float s = 0.f;
    for (int c = lane; c < K; c += 64) { float v; if constexpr (sizeof(T) == 2) v = bf2f(X[(size_t)row * K + c]); else v = X[(size_t)row * K + c]; s += v * v; }
    s = wave_sum(s);
    if (lane == 0) r[row] = 1.0f / sqrtf(s / (float)K + EPS);
}
template <int NC, class F>
__global__ void __launch_bounds__(256) ngemm(const bf16* __restrict__ A, int lda, int K, int N, int ldw, const float* __restrict__ kscale, F f) {
    const int n = blockIdx.x * 256 + threadIdx.x; const int m0 = blockIdx.y * 16;
    if (n >= N) return;
    const float* wp[NC];
#pragma unroll
    for (int j = 0; j < NC; ++j) wp[j] = f.col(n, j);
    float acc[NC][16];
#pragma unroll
    for (int j = 0; j < NC; ++j)
#pragma unroll
        for (int r = 0; r < 16; ++r) acc[j][r] = 0.f;
    for (int k = 0; k < K; k += 8) {
        float w[NC][8];
#pragma unroll
        for (int j = 0; j < NC; ++j)
#pragma unroll
            for (int e = 0; e < 8; ++e) w[j][e] = rbf(wp[j][(size_t)(k + e) * ldw] * (kscale ? kscale[k + e] : 1.f));
#pragma unroll
        for (int r = 0; r < 16; ++r) {
            const uint4 a = *(const uint4*)(A + (size_t)(m0 + r) * lda + k);
            const float av[8] = {__uint_as_float(a.x << 16), __uint_as_float(a.x & 0xffff0000u), __uint_as_float(a.y << 16), __uint_as_float(a.y & 0xffff0000u),
                                 __uint_as_float(a.z << 16), __uint_as_float(a.z & 0xffff0000u), __uint_as_float(a.w << 16), __uint_as_float(a.w & 0xffff0000u)};
#pragma unroll
            for (int j = 0; j < NC; ++j)
#pragma unroll
                for (int e = 0; e < 8; ++e) acc[j][r] += av[e] * w[j][e];
        }
    }
#pragma unroll
    for (int r = 0; r < 16; ++r) { float v[NC];
#pragma unroll
        for (int j = 0; j < NC; ++j) v[j] = acc[j][r];
        f.store(m0 + r, n, v); }
}
struct FStore { const float* W; bf16* O; int ldo; int pad;
    __device__ const float* col(int n, int) const { return W + n; }
    __device__ void store(int m, int n, const float (&v)[1]) const { O[(size_t)m * ldo + n] = f2bf(v[0]); } };
struct FGelu { const float* W; bf16* O; int ldo; int pad;
    __device__ const float* col(int n, int) const { return W + n; }
    __device__ void store(int m, int n, const float (&v)[1]) const { O[(size_t)m * ldo + n] = f2bf(gelu_tanh(v[0])); } };
struct FGate { const float* W; bf16* O; const float* b;
    __device__ const float* col(int n, int) const { return W + n; }
    __device__ void store(int m, int n, const float (&v)[1]) const { O[(size_t)m * 4096 + n] = f2bf(sigmoidf_(v[0] + b[n])); } };
struct FKpe { const float* W; bf16* O; const float* COS; const float* SIN;
    __device__ const float* col(int n, int j) const { return W + O2 + n + 32 * j; }
    __device__ void store(int m, int n, const float (&v)[2]) const { const float c = COS[m * 32 + n], s = SIN[m * 32 + n];
        O[(size_t)m * 64 + n] = f2bf(v[0] * c - v[1] * s); O[(size_t)m * 64 + 32 + n] = f2bf(v[1] * c + v[0] * s); } };
struct FQnope { const float* W; bf16* Q; const float* rq;
    __device__ const float* col(int n, int) const { return W + (n >> 7) * DQK + (n & 127); }
    __device__ void store(int m, int n, const float (&v)[1]) const { Q[(size_t)m * 3072 + (n >> 7) * DQK + (n & 127)] = f2bf(v[0] * rq[m] * QSCALE); } };
struct FQpe { const float* W; bf16* Q; const float* rq; const float* COS; const float* SIN;
    __device__ const float* col(int n, int j) const { return W + (n >> 5) * DQK + 128 + (n & 31) + 32 * j; }
    __device__ void store(int m, int n, const float (&v)[2]) const { const int h = n >> 5, i = n & 31; const float c = COS[m * 32 + i], s = SIN[m * 32 + i], sc = rq[m] * QSCALE;
        const float a = v[0] * sc, b = v[1] * sc; bf16* q = Q + (size_t)m * 3072 + h * DQK + 128;
        q[i] = f2bf(a * c - b * s); q[32 + i] = f2bf(b * c + a * s); } };
struct FKV { const float* W; bf16* KN; bf16* V; const float* rkv;
    __device__ const float* col(int n, int) const { return W + n; }
    __device__ void store(int m, int n, const float (&v)[1]) const { const int h = n >> 8, c = n & 255; const float o = v[0] * rkv[m];
        if (c < 128) KN[(size_t)m * 2048 + h * 128 + c] = f2bf(o); else V[(size_t)m * 2048 + h * 128 + (c - 128)] = f2bf(o); } };
struct FYs { const float* W; bf16* YS; const bf16* G;
    __device__ const float* col(int n, int) const { return W + n; }
    __device__ void store(int m, int n, const float (&v)[1]) const { YS[(size_t)m * 2048 + n] = f2bf(bf2f(G[(size_t)m * 4096 + 2048 + n]) * v[0]); } };
struct FMg { const float* W; bf16* MG; const bf16* G; const bf16* YS;
    __device__ const float* col(int n, int) const { return W + n; }
    __device__ void store(int m, int n, const float (&v)[1]) const { MG[(size_t)m * 2048 + n] = f2bf(bf2f(G[(size_t)m * 4096 + n]) * v[0] + bf2f(YS[(size_t)m * 2048 + n])); } };
struct FH1 { const float* W; const float* x; float* H1; bf16* H1B;
    __device__ const float* col(int n, int) const { return W + n; }
    __device__ void store(int m, int n, const float (&v)[1]) const { const float h = x[(size_t)m * 2048 + n] + v[0]; H1[(size_t)m * 2048 + n] = h; H1B[(size_t)m * 2048 + n] = f2bf(h); } };
struct FAct { const float* Wg; const float* Wu; bf16* ACT; const float* rf;
    __device__ const float* col(int n, int j) const { return (j ? Wu : Wg) + n; }
    __device__ void store(int m, int n, const float (&v)[2]) const { const float r = rf[m], g = v[0] * r, u = v[1] * r; ACT[(size_t)m * DFF + n] = f2bf(g * sigmoidf_(g) * u); } };
struct FH2 { const float* W; float* H;
    __device__ const float* col(int n, int) const { return W + n; }
    __device__ void store(int m, int n, const float (&v)[1]) const { H[(size_t)m * 2048 + n] += v[0]; } };

__global__ void __launch_bounds__(256) k_sgu_naive(const bf16* __restrict__ U, const bf16* __restrict__ GV, const float* __restrict__ rv, const float* __restrict__ gn,
                                                    const float* __restrict__ ws, const float* __restrict__ bs, bf16* __restrict__ SG) {
    const int idx = blockIdx.x * 256 + threadIdx.x; const int m = idx >> 10, c = idx & 1023, g = c >> 7, t = m & 127, mb = m - t;
    float s = 0.f;
    for (int j = 0; j <= t; ++j) s += rbf(ws[(g * CHUNK + t) * CHUNK + j]) * rbf(bf2f(GV[(size_t)(mb + j) * SGW + c]) * rv[mb + j] * gn[c]);
    SG[(size_t)m * SGW + c] = f2bf(bf2f(U[(size_t)m * SGW + c]) * (s + bs[g * CHUNK + t]));
}
__global__ void __launch_bounds__(128) k_attn_naive(const bf16* __restrict__ Q, const bf16* __restrict__ KN, const bf16* __restrict__ KPE, const bf16* __restrict__ V, bf16* __restrict__ AO) {
    __shared__ float qs[DQK]; __shared__ float sc[SEQ]; __shared__ float red[128];
    const int tid = threadIdx.x; const int q = blockIdx.x % SEQ, bh = blockIdx.x / SEQ, h = bh % NH, b = bh / NH;
    const size_t mq = (size_t)b * SEQ + q;
    for (int i = tid; i < DQK; i += 128) qs[i] = bf2f(Q[mq * 3072 + h * DQK + i]);
    __syncthreads();
    float mx = -1e30f;
    for (int j = tid; j <= q; j += 128) { const size_t mk = (size_t)b * SEQ + j; float s = 0.f;
        const bf16* kr = KN + mk * 2048 + h * 128; for (int d = 0; d < 128; ++d) s += qs[d] * bf2f(kr[d]);
        const bf16* kp = KPE + mk * 64; for (int d = 0; d < 64; ++d) s += qs[128 + d] * bf2f(kp[d]);
        sc[j] = s; mx = fmaxf(mx, s); }
    red[tid] = mx; __syncthreads();
    for (int o = 64; o > 0; o >>= 1) { if (tid < o) red[tid] = fmaxf(red[tid], red[tid + o]); __syncthreads(); }
    mx = red[0]; __syncthreads();
    float l = 0.f;
    for (int j = tid; j <= q; j += 128) { const float p = exp2f(sc[j] - mx); l += p; sc[j] = rbf(p); }
    red[tid] = l; __syncthreads();
    for (int o = 64; o > 0; o >>= 1) { if (tid < o) red[tid] += red[tid + o]; __syncthreads(); }
    l = red[0];
    float o = 0.f;
    for (int j = 0; j <= q; ++j) o += sc[j] * bf2f(V[((size_t)b * SEQ + j) * 2048 + h * 128 + tid]);
    AO[mq * 2048 + h * 128 + tid] = f2bf(o / l);
}
__global__ void __launch_bounds__(256) k_final_norm(const float* __restrict__ H, const float* __restrict__ g, float* __restrict__ out) {
    const int lane = threadIdx.x & 63, row = blockIdx.x * 4 + (threadIdx.x >> 6);
    const float* hr = H + (size_t)row * DM; float s = 0.f;
    for (int c = lane; c < DM; c += 64) { const float v = hr[c]; s += v * v; }
    const float r = 1.0f / sqrtf(wave_sum(s) * (1.0f / DM) + EPS);
    for (int c = lane; c < DM; c += 64) out[(size_t)row * DM + c] = hr[c] * r * g[c];
}

template <int NC, class F> static void run_ngemm(hipStream_t st, const bf16* A, int lda, int K, int N, int ldw, const float* ks, F f) {
    hipLaunchKernelGGL((ngemm<NC, F>), dim3((N + 255) / 256, M / 16), dim3(256), 0, st, A, lda, K, N, ldw, ks, f);
}

extern "C" void kernel_launch(void* const* d_in, const int* in_sizes, int n_in, void* d_out, int out_size, void* d_ws, size_t ws_size, hipStream_t stream) {
    if (n_in != 20 || ws_size < WS_END || out_size != M * DM) { fprintf(stderr, "kernel_launch: unexpected shapes (n_in %d ws %zu out %d)\n", n_in, ws_size, out_size); return; }
    const float* x = (const float*)d_in[0]; const int* pos = (const int*)d_in[1]; const float* g_mix = (const float*)d_in[2]; const float* w_in = (const float*)d_in[3];
    const float* b_gate = (const float*)d_in[4]; const float* g_q = (const float*)d_in[5]; const float* w_uq = (const float*)d_in[6]; const float* g_kv = (const float*)d_in[7];
    const float* w_ukv = (const float*)d_in[8]; const float* w_oa = (const float*)d_in[9]; const float* g_sgu = (const float*)d_in[10]; const float* w_sgu = (const float*)d_in[11];
    const float* b_sgu = (const float*)d_in[12]; const float* w_os = (const float*)d_in[13]; const float* w_out = (const float*)d_in[14]; const float* g_ffn = (const float*)d_in[15];
    const float* w_g = (const float*)d_in[16]; const float* w_u = (const float*)d_in[17]; const float* w_d = (const float*)d_in[18]; const float* g_fin = (const float*)d_in[19];
    unsigned char* ws = (unsigned char*)d_ws; float* out = (float*)d_out;
    float* COS = (float*)(ws + WS_COS); float* SIN = (float*)(ws + WS_SIN);
    float* RQ = (float*)(ws + WS_RQ); float* RKV = (float*)(ws + WS_RKV); float* RV = (float*)(ws + WS_RV); float* RF = (float*)(ws + WS_RF);
    bf16* XN = (bf16*)(ws + WS_XN); bf16* AO = (bf16*)(ws + WS_AO); bf16* U = (bf16*)(ws + WS_U); bf16* GV = (bf16*)(ws + WS_GV); bf16* YS = (bf16*)(ws + WS_YS);
    bf16* QL = (bf16*)(ws + WS_QL); bf16* KVL = (bf16*)(ws + WS_KVL); bf16* KPE = (bf16*)(ws + WS_KPE); bf16* SG = (bf16*)(ws + WS_SG); bf16* Q = (bf16*)(ws + WS_Q);
    bf16* KN = (bf16*)(ws + WS_KN); bf16* V = (bf16*)(ws + WS_V); bf16* MG = (bf16*)(ws + WS_MG); float* H1 = (float*)(ws + WS_H1); bf16* H1B = (bf16*)(ws + WS_H1B);
    bf16* ACT = (bf16*)(ws + WS_ACT); bf16* G = (bf16*)d_out;
    hipLaunchKernelGGL(k_rope_tab, dim3(M * 32 / 256), dim3(256), 0, stream, pos, COS, SIN);
    hipLaunchKernelGGL(k_rmsnorm_x, dim3(M / 4), dim3(256), 0, stream, x, g_mix, XN);
    run_ngemm<1>(stream, XN, DM, DM, 512, DIN, nullptr, FStore{w_in, QL, 512});
    run_ngemm<1>(stream, XN, DM, DM, 512, DIN, nullptr, FStore{w_in + O1, KVL, 512});
    run_ngemm<2>(stream, XN, DM, DM, 32, DIN, nullptr, FKpe{w_in, KPE, COS, SIN});
    run_ngemm<1>(stream, XN, DM, DM, 1024, DIN, nullptr, FGelu{w_in + O3, U, 1024});
    run_ngemm<1>(stream, XN, DM, DM, 1024, DIN, nullptr, FGelu{w_in + O3 + 1024, GV, 1024});
    run_ngemm<1>(stream, XN, DM, DM, 4096, DIN, nullptr, FGate{w_in + O4, G, b_gate});
    hipLaunchKernelGGL((k_rowscale<bf16>), dim3(M / 4), dim3(256), 0, stream, (const bf16*)QL, 512, RQ);
    hipLaunchKernelGGL((k_rowscale<bf16>), dim3(M / 4), dim3(256), 0, stream, (const bf16*)KVL, 512, RKV);
    hipLaunchKernelGGL((k_rowscale<bf16>), dim3(M / 4), dim3(256), 0, stream, (const bf16*)GV, 1024, RV);
    run_ngemm<1>(stream, QL, 512, 512, 2048, 3072, g_q, FQnope{w_uq, Q, RQ});
    run_ngemm<2>(stream, QL, 512, 512, 512, 3072, g_q, FQpe{w_uq, Q, RQ, COS, SIN});
    run_ngemm<1>(stream, KVL, 512, 512, 4096, 4096, g_kv, FKV{w_ukv, KN, V, RKV});
    hipLaunchKernelGGL(k_sgu_naive, dim3(M * SGW / 256), dim3(256), 0, stream, (const bf16*)U, (const bf16*)GV, (const float*)RV, g_sgu, w_sgu, b_sgu, SG);
    hipLaunchKernelGGL(k_attn_naive, dim3(BATCH * NH * SEQ), dim3(128), 0, stream, (const bf16*)Q, (const bf16*)KN, (const bf16*)KPE, (const bf16*)V, AO);
    run_ngemm<1>(stream, SG, 1024, 1024, 2048, 2048, nullptr, FYs{w_os, YS, G});
    run_ngemm<1>(stream, AO, 2048, 2048, 2048, 2048, nullptr, FMg{w_oa, MG, G, YS});
    run_ngemm<1>(stream, MG, 2048, 2048, 2048, 2048, nullptr, FH1{w_out, x, H1, H1B});
    hipLaunchKernelGGL((k_rowscale<float>), dim3(M / 4), dim3(256), 0, stream, (const float*)H1, 2048, RF);
    run_ngemm<2>(stream, H1B, 2048, 2048, DFF, DFF, g_ffn, FAct{w_g, w_u, ACT, RF});
    run_ngemm<1>(stream, ACT, DFF, DFF, 2048, 2048, nullptr, FH2{w_d, H1});
    hipLaunchKernelGGL(k_final_norm, dim3(M / 4), dim3(256), 0, stream, (const float*)H1, g_fin, out);
}
```

```cpp
#include <hip/hip_runtime.h>
#include <cstdio>
#include <cstdint>

typedef unsigned short bf16;
constexpr int BATCH = 4, SEQ = 2048, DM = 2048, M = BATCH * SEQ;
constexpr int NH = 16, DNOPE = 128, DROPE = 64, DV = 128, DQK = 192, QLR = 512, KVLR = 512;
constexpr int SGW = 1024, SGG = 8, SGD = 128, CHUNK = 128;
constexpr int DFF = 5632, DIN = 7232;
constexpr int O1 = 512, O2 = 1024, O3 = 1088, O4 = 3136;
constexpr float EPS = 1e-6f;
constexpr float QSCALE = 0.07216878364870322f * 1.4426950408889634f;
constexpr int NIN_T = 7424;

constexpr size_t MiB = 1u << 20;
constexpr size_t WS_CTL = 0, CTL_ZERO_BYTES = 64 * 1024;
constexpr size_t WS_COS = 1 * MiB, WS_SIN = 2 * MiB;
constexpr size_t WS_QSS = 3 * MiB, WS_KVSS = WS_QSS + 256 * 1024, WS_VSS = WS_KVSS + 256 * 1024;
constexpr size_t WS_H1SS = 4 * MiB, WS_H2SS = 5 * MiB;
constexpr size_t WS_RQ = 6 * MiB, WS_RKV = WS_RQ + 32768, WS_RV = WS_RKV + 32768, WS_RF = WS_RV + 32768, WS_RO = WS_RF + 32768;
constexpr size_t WS_WIN = 8 * MiB, WS_WQKV = 37 * MiB, WS_WOSGU = 44 * MiB, WS_WOATT = 48 * MiB, WS_WOUT = 56 * MiB;
constexpr size_t WS_XN = 64 * MiB, WS_AO = 64 * MiB;
constexpr size_t WS_U = 96 * MiB, WS_GV = 112 * MiB, WS_YS = 96 * MiB;
constexpr size_t WS_QKVL = 128 * MiB, WS_KPE = 144 * MiB, WS_SG = 145 * MiB, WS_Q = 161 * MiB, WS_KN = 209 * MiB, WS_V = 241 * MiB;
constexpr size_t WS_MG = 128 * MiB;
constexpr size_t WS_H1 = 161 * MiB, WS_H1B = 225 * MiB, WS_WDOWN = 257 * MiB;
constexpr size_t WS_ACT = 8 * MiB;
constexpr size_t WS_END = 279 * MiB;

__device__ __forceinline__ float bf2f(bf16 v) { return __uint_as_float((unsigned)v << 16); }
__device__ __forceinline__ bf16 f2bf(float f) { unsigned u = __float_as_uint(f); return (bf16)((u + 0x7fffu + ((u >> 16) & 1u)) >> 16); }
__device__ __forceinline__ float rbf(float f) { return bf2f(f2bf(f)); }
__device__ __forceinline__ float sigmoidf_(float x) { return __builtin_amdgcn_rcpf(1.f + __builtin_amdgcn_exp2f(-x * 1.4426950408889634f)); }
__device__ __forceinline__ float gelu_tanh(float x) { const float y = 0.7978845608028654f * (x + 0.044715f * x * x * x); return x * sigmoidf_(2.f * y); }
__device__ __forceinline__ float wave_sum(float v) {
#pragma unroll
    for (int o = 1; o < 64; o <<= 1) v += __shfl_xor(v, o);
    return v;
}
__global__ void __launch_bounds__(256) k_rope_tab(const int* __restrict__ pos, float* __restrict__ COS, float* __restrict__ SIN) {
    const int idx = blockIdx.x * 256 + threadIdx.x; if (idx >= M * 32) return;
    const int m = idx >> 5, i = idx & 31;
    const float inv = powf(10000.0f, -(float)(2 * i) / 64.0f);
    const float ang = (float)pos[m] * inv;
    COS[idx] = cosf(ang); SIN[idx] = sinf(ang);
}
__global__ void __launch_bounds__(256) k_rmsnorm_x(const float* __restrict__ x, const float* __restrict__ g, bf16* __restrict__ XN) {
    const int lane = threadIdx.x & 63, row = blockIdx.x * 4 + (threadIdx.x >> 6);
    const float* xr = x + (size_t)row * DM; float s = 0.f;
    for (int c = lane; c < DM; c += 64) { const float v = xr[c]; s += v * v; }
    const float r = 1.0f / sqrtf(wave_sum(s) * (1.0f / DM) + EPS);
    for (int c = lane; c < DM; c += 64) XN[(size_t)row * DM + c] = f2bf(xr[c] * r * g[c]);
}
template <class T> __global__ void __launch_bounds__(256) k_rowscale(const T* __restrict__ X, int ld, int K, float* __restrict__ r) {
    const int lane = threadIdx.x & 63, row = blockIdx.x * 4 + (threadIdx.x >> 6);
    float s = 0.f;
    for (int c = lane; c < K; c += 64) { float v; if constexpr (sizeof(T) == 2) v = bf2f(X[(size_t)row * ld + c]); else v = X[(size_t)row * ld + c]; s += v * v; }
    s = wave_sum(s);
    if (lane == 0) r[row] = 1.0f / sqrtf(s / (float)K + EPS);
}
template <int NC, class F>
__global__ void __launch_bounds__(256) ngemm(const bf16* __restrict__ A, int lda, int K, int N, int ldw, const float* __restrict__ kscale, F f) {
    const int n = blockIdx.x * 256 + threadIdx.x; const int m0 = blockIdx.y * 16;
    if (n >= N) return;
    const float* wp[NC];
#pragma unroll
    for (int j = 0; j < NC; ++j) wp[j] = f.col(n, j);
    float acc[NC][16];
#pragma unroll
    for (int j = 0; j < NC; ++j)
#pragma unroll
        for (int r = 0; r < 16; ++r) acc[j][r] = 0.f;
    for (int k = 0; k < K; k += 8) {
        float w[NC][8];
#pragma unroll
        for (int j = 0; j < NC; ++j)
#pragma unroll
            for (int e = 0; e < 8; ++e) w[j][e] = rbf(wp[j][(size_t)(k + e) * ldw] * (kscale ? kscale[k + e] : 1.f));
#pragma unroll
        for (int r = 0; r < 16; ++r) {
            const uint4 a = *(const uint4*)(A + (size_t)(m0 + r) * lda + k);
            const float av[8] = {__uint_as_float(a.x << 16), __uint_as_float(a.x & 0xffff0000u), __uint_as_float(a.y << 16), __uint_as_float(a.y & 0xffff0000u),
                                 __uint_as_float(a.z << 16), __uint_as_float(a.z & 0xffff0000u), __uint_as_float(a.w << 16), __uint_as_float(a.w & 0xffff0000u)};
#pragma unroll
            for (int j = 0; j < NC; ++j)
#pragma unroll
                for (int e = 0; e < 8; ++e) acc[j][r] += av[e] * w[j][e];
        }
    }
#pragma unroll
    for (int r = 0; r < 16; ++r) { float v[NC];
#pragma unroll
        for (int j = 0; j < NC; ++j) v[j] = acc[j][r];
        f.store(m0 + r, n, v); }
}
struct FStore { const float* W; bf16* O; int ldo; int pad;
    __device__ const float* col(int n, int) const { return W + n; }
    __device__ void store(int m, int n, const float (&v)[1]) const { O[(size_t)m * ldo + n] = f2bf(v[0]); } };
struct FGelu { const float* W; bf16* O; int ldo; int pad;
    __device__ const float* col(int n, int) const { return W + n; }
    __device__ void store(int m, int n, const float (&v)[1]) const { O[(size_t)m * ldo + n] = f2bf(gelu_tanh(v[0])); } };
struct FGate { const float* W; bf16* O; const float* b;
    __device__ const float* col(int n, int) const { return W + n; }
    __device__ void store(int m, int n, const float (&v)[1]) const { O[(size_t)m * 4096 + n] = f2bf(sigmoidf_(v[0] + b[n])); } };
struct FKpe { const float* W; bf16* O; const float* COS; const float* SIN;
    __device__ const float* col(int n, int j) const { return W + O2 + n + 32 * j; }
    __device__ void store(int m, int n, const float (&v)[2]) const { const float c = COS[m * 32 + n], s = SIN[m * 32 + n];
        O[(size_t)m * 64 + n] = f2bf(v[0] * c - v[1] * s); O[(size_t)m * 64 + 32 + n] = f2bf(v[1] * c + v[0] * s); } };
struct FQnope { const float* W; bf16* Q; const float* rq;
    __device__ const float* col(int n, int) const { return W + (n >> 7) * DQK + (n & 127); }
    __device__ void store(int m, int n, const float (&v)[1]) const { Q[(size_t)m * 3072 + (n >> 7) * DQK + (n & 127)] = f2bf(v[0] * rq[m] * QSCALE); } };
struct FQpe { const float* W; bf16* Q; const float* rq; const float* COS; const float* SIN;
    __device__ const float* col(int n, int j) const { return W + (n >> 5) * DQK + 128 + (n & 31) + 32 * j; }
    __device__ void store(int m, int n, const float (&v)[2]) const { const int h = n >> 5, i = n & 31; const float c = COS[m * 32 + i], s = SIN[m * 32 + i], sc = rq[m] * QSCALE;
        const float a = v[0] * sc, b = v[1] * sc; bf16* q = Q + (size_t)m * 3072 + h * DQK + 128;
        q[i] = f2bf(a * c - b * s); q[32 + i] = f2bf(b * c + a * s); } };
struct FKV { const float* W; bf16* KN; bf16* V; const float* rkv;
    __device__ const float* col(int n, int) const { return W + n; }
    __device__ void store(int m, int n, const float (&v)[1]) const { const int h = n >> 8, c = n & 255; const float o = v[0] * rkv[m];
        if (c < 128) KN[(size_t)m * 2048 + h * 128 + c] = f2bf(o); else V[(size_t)m * 2048 + h * 128 + (c - 128)] = f2bf(o); } };
struct FYs { const float* W; bf16* YS; const bf16* G;
    __device__ const float* col(int n, int) const { return W + n; }
    __device__ void store(int m, int n, const float (&v)[1]) const { YS[(size_t)m * 2048 + n] = f2bf(bf2f(G[(size_t)m * 4096 + 2048 + n]) * v[0]); } };
struct FMg { const float* W; bf16* MG; const bf16* G; const bf16* YS;
    __device__ const float* col(int n, int) const { return W + n; }
    __device__ void store(int m, int n, const float (&v)[1]) const { MG[(size_t)m * 2048 + n] = f2bf(bf2f(G[(size_t)m * 4096 + n]) * v[0] + bf2f(YS[(size_t)m * 2048 + n])); } };
struct FH1 { const float* W; const float* x; float* H1; bf16* H1B;
    __device__ const float* col(int n, int) const { return W + n; }
    __device__ void store(int m, int n, const float (&v)[1]) const { const float h = x[(size_t)m * 2048 + n] + v[0]; H1[(size_t)m * 2048 + n] = h; H1B[(size_t)m * 2048 + n] = f2bf(h); } };
struct FAct { const float* Wg; const float* Wu; bf16* ACT; const float* rf;
    __device__ const float* col(int n, int j) const { return (j ? Wu : Wg) + n; }
    __device__ void store(int m, int n, const float (&v)[2]) const { const float r = rf[m], g = v[0] * r, u = v[1] * r; ACT[(size_t)m * DFF + n] = f2bf(g * sigmoidf_(g) * u); } };
struct FH2 { const float* W; float* H;
    __device__ const float* col(int n, int) const { return W + n; }
    __device__ void store(int m, int n, const float (&v)[1]) const { H[(size_t)m * 2048 + n] += v[0]; } };

__global__ void __launch_bounds__(256) k_sgu_naive(const bf16* __restrict__ U, const bf16* __restrict__ GV, const float* __restrict__ rv, const float* __restrict__ gn,
                                                    const float* __restrict__ ws, const float* __restrict__ bs, bf16* __restrict__ SG) {
    const int idx = blockIdx.x * 256 + threadIdx.x; const int m = idx >> 10, c = idx & 1023, g = c >> 7, t = m & 127, mb = m - t;
    float s = 0.f;
    for (int j = 0; j <= t; ++j) s += rbf(ws[(g * CHUNK + t) * CHUNK + j]) * rbf(bf2f(GV[(size_t)(mb + j) * SGW + c]) * rv[mb + j] * gn[c]);
    SG[(size_t)m * SGW + c] = f2bf(bf2f(U[(size_t)m * SGW + c]) * (s + bs[g * CHUNK + t]));
}
__global__ void __launch_bounds__(128) k_attn_naive(const bf16* __restrict__ Q, const bf16* __restrict__ KN, const bf16* __restrict__ KPE, const bf16* __restrict__ V, bf16* __restrict__ AO) {
    __shared__ float qs[DQK]; __shared__ float sc[SEQ]; __shared__ float red[128];
    const int tid = threadIdx.x; const int q = blockIdx.x % SEQ, bh = blockIdx.x / SEQ, h = bh % NH, b = bh / NH;
    const size_t mq = (size_t)b * SEQ + q;
    for (int i = tid; i < DQK; i += 128) qs[i] = bf2f(Q[mq * 3072 + h * DQK + i]);
    __syncthreads();
    float mx = -1e30f;
    for (int j = tid; j <= q; j += 128) { const size_t mk = (size_t)b * SEQ + j; float s = 0.f;
        const bf16* kr = KN + mk * 2048 + h * 128; for (int d = 0; d < 128; ++d) s += qs[d] * bf2f(kr[d]);
        const bf16* kp = KPE + mk * 64; for (int d = 0; d < 64; ++d) s += qs[128 + d] * bf2f(kp[d]);
        sc[j] = s; mx = fmaxf(mx, s); }
    red[tid] = mx; __syncthreads();
    for (int o = 64; o > 0; o >>= 1) { if (tid < o) red[tid] = fmaxf(red[tid], red[tid + o]); __syncthreads(); }
    mx = red[0]; __syncthreads();
    float l = 0.f;
    for (int j = tid; j <= q; j += 128) { const float p = exp2f(sc[j] - mx); l += p; sc[j] = rbf(p); }
    red[tid] = l; __syncthreads();
    for (int o = 64; o > 0; o >>= 1) { if (tid < o) red[tid] += red[tid + o]; __syncthreads(); }
    l = red[0];
    float o = 0.f;
    for (int j = 0; j <= q; ++j) o += sc[j] * bf2f(V[((size_t)b * SEQ + j) * 2048 + h * 128 + tid]);
    AO[mq * 2048 + h * 128 + tid] = f2bf(o / l);
}
__global__ void __launch_bounds__(256) k_final_norm(const float* __restrict__ H, const float* __restrict__ g, float* __restrict__ out) {
    const int lane = threadIdx.x & 63, row = blockIdx.x * 4 + (threadIdx.x >> 6);
    const float* hr = H + (size_t)row * DM; float s = 0.f;
    for (int c = lane; c < DM; c += 64) { const float v = hr[c]; s += v * v; }
    const float r = 1.0f / sqrtf(wave_sum(s) * (1.0f / DM) + EPS);
    for (int c = lane; c < DM; c += 64) out[(size_t)row * DM + c] = hr[c] * r * g[c];
}


namespace pg8 {
#define PG8_LAS __attribute__((address_space(3)))
typedef unsigned short bf16_t;
typedef short bf16x8 __attribute__((ext_vector_type(8)));
typedef float f32x4 __attribute__((ext_vector_type(4)));
typedef float f32x2 __attribute__((ext_vector_type(2)));
typedef unsigned u32x4 __attribute__((ext_vector_type(4)));
typedef unsigned u32x2 __attribute__((ext_vector_type(2)));
constexpr int BM = 256, BK = 64, HALF = 128, HTB = HALF * BK * 2  , STAGE_BYTES = 8 * HTB, NXCD = 8, WGM = 8;

__host__ __device__ __forceinline__ int lds_byte(int r, int c) { const int st = (r >> 4) * 2 + (c >> 5), rr = r & 15, cc = c & 31, ob = rr * 64 + cc * 2; return st * 1024 + (ob ^ (((ob >> 9) & 1) << 5)); }
__host__ __device__ __forceinline__ void stage_rc(int b, int& R, int& C) { const int st = b / 1024, sb = b % 1024, swz = sb ^ (((sb >> 9) & 1) << 5); R = (st >> 1) * 16 + swz / 64; C = (st & 1) * 32 + (swz % 64) / 2; }
__host__ __device__ __forceinline__ int perm32(int rho) { const int n = rho >> 4, i = rho & 15; return 8 * (i >> 2) + 4 * n + (i & 3); }

struct Unit { int pm, pn, aoff; };
struct Gemm { const bf16_t* A; const bf16_t* Bt; int lda, ldb, K; };

struct StaticOrder {
    int nM, nN, nwg, G, c, split, split_aoff;
    __host__ __device__ void init(int M_, int N_, int G_, int c_, int split_ = 1 << 30, int split_aoff_ = 0) { nM = M_ / BM; nN = N_ / BM; nwg = nM * nN; G = G_; c = c_; split = split_; split_aoff = split_aoff_; }
    __host__ __device__ bool next(int i, Unit& u) const {
        const long L = (long)i * G + c; if (L >= nwg) return false;
        int wgid = (int)L; { const int q = nwg / NXCD, r = nwg % NXCD, xcd = wgid % NXCD, off = wgid / NXCD; wgid = (xcd < r ? xcd * (q + 1) : r * (q + 1) + (xcd - r) * q) + off; }
        const int nig = WGM * nN, gid = wgid / nig, fm = gid * WGM, gsz = (nM - fm) < WGM ? (nM - fm) : WGM;
        u.pm = fm + ((wgid % nig) % gsz); u.pn = (wgid % nig) / gsz; u.aoff = (u.pn >= split) ? split_aoff : 0; return true;
    }
    __device__ __forceinline__ void a_ready(const Unit&) const {}
    __device__ __forceinline__ void done(const Unit&) const {}
};
__device__ __forceinline__ unsigned cvt_pk_bf16(float lo, float hi) { unsigned r; asm volatile("v_cvt_pk_bf16_f32 %0, %1, %2" : "=v"(r) : "v"(lo), "v"(hi)); return r; }

template <class Epi, class Sched, bool ALIGN_EPI = false, bool SP2 = false>
__device__ __forceinline__ void gemm_phase(PG8_LAS unsigned char* lds, const Gemm g, const Sched& S, const Epi& E) {
    const int tid = threadIdx.x, wid = __builtin_amdgcn_readfirstlane(tid >> 6), lane = tid & 63, wr = wid >> 2, wc = wid & 3, fr = lane & 15, fq = lane >> 4;
    const int K = g.K, nt = K / BK;
    unsigned voffA[2], voffB[2];
#pragma unroll
    for (int i = 0; i < 2; ++i) { int R, C; stage_rc(tid * 16 + i * 8192, R, C); const int Rb = Epi::PERM ? ((R & ~31) + perm32(R & 31)) : R;
        voffA[i] = (unsigned)(R * g.lda + C) * 2u; voffB[i] = (unsigned)(Rb * g.ldb + C) * 2u; }
    const size_t kstep = (size_t)(BK * 2);
    const size_t hsA = (size_t)HALF * g.lda * 2, hsB = (size_t)HALF * g.ldb * 2;
    const size_t tsA = 2 * hsA, tsB = 2 * hsB;
    const unsigned ldsw = (unsigned)wid * 1024u;
    const int aoff = lds_byte(wr * 64 + fr, fq * 8), boff = lds_byte(wc * 32 + fr, fq * 8);
#define PG8_SA(b, h) (((b) * 2 + (h)) * HTB)
#define PG8_SB(b, h) ((4 + (b) * 2 + (h)) * HTB)
#define PG8_STAGE(bufoff, gbase, voff) do { _Pragma("unroll") for (int _i = 0; _i < 2; ++_i) \
        __builtin_amdgcn_global_load_lds((const unsigned*)((const char*)(gbase) + (voff)[_i]), (PG8_LAS unsigned*)(lds + (bufoff) + ldsw + _i * 8192), 16, 0, 0); } while (0)
#define PG8_LDA(dst, b, h) do { _Pragma("unroll") for (int m = 0; m < 4; ++m) _Pragma("unroll") for (int k = 0; k < 2; ++k) dst[m][k] = *(const PG8_LAS bf16x8*)(lds + PG8_SA(b, h) + aoff + m * 2048 + k * 1024); } while (0)
#define PG8_LDB(dst, b, h) do { _Pragma("unroll") for (int n = 0; n < 2; ++n) _Pragma("unroll") for (int k = 0; k < 2; ++k) dst[n][k] = *(const PG8_LAS bf16x8*)(lds + PG8_SB(b, h) + boff + n * 2048 + k * 1024); } while (0)
#define PG8_MMA(ai, bj, At, Bt) do { __builtin_amdgcn_s_setprio(1); _Pragma("unroll") for (int m = 0; m < 4; ++m) _Pragma("unroll") for (int n = 0; n < 2; ++n) _Pragma("unroll") for (int k = 0; k < 2; ++k) \
        acc[ai][bj][m][n] = __builtin_amdgcn_mfma_f32_16x16x32_bf16(Bt[n][k], At[m][k], acc[ai][bj][m][n], 0, 0, 0); __builtin_amdgcn_s_setprio(0); } while (0)
#define PG8_WAIT_V(n) asm volatile("s_waitcnt vmcnt(" #n ")" ::: "memory")
#define PG8_WAIT_L(n) asm volatile("s_waitcnt lgkmcnt(" #n ")" ::: "memory")
#define PG8_BAR __builtin_amdgcn_s_barrier()
#define PG8_SCHED __builtin_amdgcn_sched_barrier(0)
    Unit cur, nxt; int ui = 0;
    if (!S.next(0, cur)) return;
    f32x4 acc[2][2][4][2];
#pragma unroll
    for (int a = 0; a < 2; ++a)
#pragma unroll
        for (int b = 0; b < 2; ++b)
#pragma unroll
            for (int m = 0; m < 4; ++m)
#pragma unroll
                for (int n = 0; n < 2; ++n) acc[a][b][m][n] = (f32x4){0.f, 0.f, 0.f, 0.f};
    bf16x8 At[4][2], B0[2][2], B1[2][2];
    const char* cA = (const char*)g.A + (size_t)cur.pm * tsA + (size_t)cur.aoff * 2; const char* cB = (const char*)g.Bt + (size_t)cur.pn * tsB;
    S.a_ready(cur);
    if constexpr (SP2) {
        PG8_STAGE(PG8_SB(0, 0), cB, voffB); PG8_STAGE(PG8_SB(0, 1), cB + hsB, voffB); PG8_STAGE(PG8_SA(0, 0), cA, voffA); PG8_STAGE(PG8_SA(0, 1), cA + hsA, voffA);
        if (wr == 1) PG8_BAR;
        PG8_WAIT_V(2); PG8_BAR;
        PG8_STAGE(PG8_SB(1, 0), cB + kstep, voffB); PG8_STAGE(PG8_SA(1, 0), cA + kstep, voffA); PG8_STAGE(PG8_SB(1, 1), cB + hsB + kstep, voffB);
        PG8_WAIT_V(6); PG8_BAR;
    } else {
        PG8_STAGE(PG8_SB(0, 0), cB, voffB); PG8_STAGE(PG8_SA(0, 0), cA, voffA); PG8_STAGE(PG8_SB(0, 1), cB + hsB, voffB); PG8_STAGE(PG8_SA(0, 1), cA + hsA, voffA);
        if (wr == 1) PG8_BAR;
        PG8_WAIT_V(4); PG8_BAR;
        PG8_STAGE(PG8_SB(1, 0), cB + kstep, voffB); PG8_STAGE(PG8_SA(1, 0), cA + kstep, voffA); PG8_STAGE(PG8_SB(1, 1), cB + hsB + kstep, voffB);
        PG8_WAIT_V(6); PG8_BAR;
    }
    for (;;) {
        const bool has_next = S.next(ui + 1, nxt);
        const char* nA = has_next ? (const char*)g.A + (size_t)nxt.pm * tsA + (size_t)nxt.aoff * 2 : cA; const char* nB = has_next ? (const char*)g.Bt + (size_t)nxt.pn * tsB : cB;
        for (int t = 0; t < nt; t += 2) {
            const bool last = (t == nt - 2);
            const char* a1 = cA + (size_t)(t + 1) * kstep;
            const char* a2 = last ? nA : cA + (size_t)(t + 2) * kstep; const char* b2 = last ? nB : cB + (size_t)(t + 2) * kstep;
            const char* a3 = a2 + kstep; const char* b3 = b2 + kstep;
            if (last && has_next) S.a_ready(nxt);
            if constexpr (SP2) {
            PG8_LDB(B0, 0, 0); PG8_LDB(B1, 0, 1); PG8_SCHED; PG8_LDA(At, 0, 0); PG8_STAGE(PG8_SA(1, 1), a1 + hsA, voffA);
            PG8_WAIT_V(8); PG8_WAIT_L(0); PG8_BAR; PG8_MMA(0, 0, At, B0); PG8_MMA(0, 1, At, B1); PG8_BAR; PG8_SCHED;
            PG8_LDA(At, 0, 1); PG8_STAGE(PG8_SB(0, 0), b2, voffB); PG8_STAGE(PG8_SB(0, 1), b2 + hsB, voffB); PG8_STAGE(PG8_SA(0, 0), a2, voffA);
            PG8_WAIT_V(8); PG8_WAIT_L(0); PG8_BAR; PG8_MMA(1, 0, At, B0); PG8_MMA(1, 1, At, B1); PG8_BAR; PG8_SCHED;
            PG8_LDB(B0, 1, 0); PG8_LDB(B1, 1, 1); PG8_SCHED; PG8_LDA(At, 1, 0); PG8_STAGE(PG8_SA(0, 1), a2 + hsA, voffA);
            PG8_WAIT_V(8); PG8_WAIT_L(0); PG8_BAR; PG8_MMA(0, 0, At, B0); PG8_MMA(0, 1, At, B1); PG8_BAR; PG8_SCHED;
            PG8_LDA(At, 1, 1); PG8_STAGE(PG8_SB(1, 0), b3, voffB); PG8_STAGE(PG8_SB(1, 1), b3 + hsB, voffB); PG8_STAGE(PG8_SA(1, 0), a3, voffA);
            PG8_WAIT_V(8); PG8_WAIT_L(0); PG8_BAR; PG8_MMA(1, 0, At, B0); PG8_MMA(1, 1, At, B1); PG8_BAR; PG8_SCHED;
            } else {
            PG8_LDB(B0, 0, 0); PG8_SCHED; PG8_LDA(At, 0, 0); PG8_STAGE(PG8_SA(1, 1), a1 + hsA, voffA);
            PG8_WAIT_L(8); PG8_BAR; PG8_WAIT_L(0); PG8_MMA(0, 0, At, B0); PG8_BAR; PG8_SCHED;
            PG8_LDB(B1, 0, 1); PG8_STAGE(PG8_SB(0, 0), b2, voffB);
            PG8_BAR; PG8_WAIT_L(0); PG8_MMA(0, 1, At, B1); PG8_BAR;
            PG8_LDA(At, 0, 1); PG8_STAGE(PG8_SA(0, 0), a2, voffA);
            PG8_BAR; PG8_WAIT_L(0); PG8_MMA(1, 0, At, B0); PG8_BAR; PG8_SCHED;
            PG8_STAGE(PG8_SB(0, 1), b2 + hsB, voffB);
            PG8_WAIT_V(6); PG8_BAR; PG8_MMA(1, 1, At, B1); PG8_BAR;
            PG8_LDB(B0, 1, 0); PG8_SCHED; PG8_LDA(At, 1, 0); PG8_STAGE(PG8_SA(0, 1), a2 + hsA, voffA);
            PG8_WAIT_L(8); PG8_BAR; PG8_WAIT_L(0); PG8_MMA(0, 0, At, B0); PG8_BAR; PG8_SCHED;
            PG8_LDB(B1, 1, 1); PG8_STAGE(PG8_SB(1, 0), b3, voffB);
            PG8_BAR; PG8_WAIT_L(0); PG8_MMA(0, 1, At, B1); PG8_BAR;
            PG8_LDA(At, 1, 1); PG8_STAGE(PG8_SA(1, 0), a3, voffA);
            PG8_BAR; PG8_WAIT_L(0); PG8_MMA(1, 0, At, B0); PG8_BAR; PG8_SCHED;
            PG8_STAGE(PG8_SB(1, 1), b3 + hsB, voffB);
            PG8_WAIT_V(6); PG8_BAR; PG8_MMA(1, 1, At, B1); PG8_BAR;
            }
        }
        if constexpr (ALIGN_EPI) { if (wr == 0) PG8_BAR; }
        if constexpr (!Epi::AFTER_DRAIN) { E(acc, cur, wr, wc, fr, fq); S.done(cur); }
        if (!has_next) break;
#pragma unroll
        for (int a = 0; a < 2; ++a)
#pragma unroll
            for (int b = 0; b < 2; ++b)
#pragma unroll
                for (int m = 0; m < 4; ++m)
#pragma unroll
                    for (int n = 0; n < 2; ++n) acc[a][b][m][n] = (f32x4){0.f, 0.f, 0.f, 0.f};
        cur = nxt; cA = nA; cB = nB; ++ui;
        if constexpr (ALIGN_EPI) { if (wr == 1) PG8_BAR; }
    }
    PG8_WAIT_V(0);
    if constexpr (!ALIGN_EPI) { if (wr == 0) PG8_BAR; }
    PG8_BAR;
    if constexpr (Epi::AFTER_DRAIN) { E.fused(acc, cur, wr, wc, fr, fq, lds, wid, lane); S.done(cur); }
#undef PG8_SA
#undef PG8_SB
#undef PG8_STAGE
#undef PG8_LDA
#undef PG8_LDB
#undef PG8_MMA
#undef PG8_WAIT_V
#undef PG8_WAIT_L
#undef PG8_BAR
#undef PG8_SCHED
}

}

namespace epi {
using pg8::f32x4; using pg8::f32x2; using pg8::u32x4; using pg8::u32x2; using pg8::Unit;
typedef __bf16 bf16x2_t __attribute__((ext_vector_type(2)));
__device__ __forceinline__ unsigned cvtpk(float lo, float hi) { f32x2 v = {lo, hi}; bf16x2_t b = __builtin_convertvector(v, bf16x2_t); return __builtin_bit_cast(unsigned, b); }
__device__ __forceinline__ float fqsum(float s) { s += __shfl_xor(s, 16); s += __shfl_xor(s, 32); return s; }
__device__ __forceinline__ float sq4(f32x4 v) { return (v[0] * v[0] + v[1] * v[1]) + (v[2] * v[2] + v[3] * v[3]); }
__device__ __forceinline__ u32x4 pack8(f32x4 a, f32x4 b) { u32x4 w; w.x = cvtpk(a[0], a[1]); w.y = cvtpk(a[2], a[3]); w.z = cvtpk(b[0], b[1]); w.w = cvtpk(b[2], b[3]); return w; }
__device__ __forceinline__ u32x2 pack4(f32x4 a) { u32x2 w; w.x = cvtpk(a[0], a[1]); w.y = cvtpk(a[2], a[3]); return w; }
__device__ __forceinline__ void unpack8(u32x4 w, f32x4& a, f32x4& b) {
    a[0] = __uint_as_float(w.x << 16); a[1] = __uint_as_float(w.x & 0xffff0000u); a[2] = __uint_as_float(w.y << 16); a[3] = __uint_as_float(w.y & 0xffff0000u);
    b[0] = __uint_as_float(w.z << 16); b[1] = __uint_as_float(w.z & 0xffff0000u); b[2] = __uint_as_float(w.w << 16); b[3] = __uint_as_float(w.w & 0xffff0000u); }
__device__ __forceinline__ f32x4 gelu4(f32x4 v) { f32x4 o; o[0] = gelu_tanh(v[0]); o[1] = gelu_tanh(v[1]); o[2] = gelu_tanh(v[2]); o[3] = gelu_tanh(v[3]); return o; }
__device__ __forceinline__ f32x4 sigm4(f32x4 v) { f32x4 o; o[0] = sigmoidf_(v[0]); o[1] = sigmoidf_(v[1]); o[2] = sigmoidf_(v[2]); o[3] = sigmoidf_(v[3]); return o; }
template <int NSLOT> __device__ __forceinline__ void row_scales(const float* SS, int row0, int fq, float inv_n, float (&rs)[2][4]) {
#pragma unroll
    for (int ai = 0; ai < 2; ++ai)
#pragma unroll
        for (int m = 0; m < 4; ++m) { const float* p = SS + (size_t)(row0 + ai * 128 + m * 16) * NSLOT + fq * (NSLOT / 4); float s;
            if constexpr (NSLOT == 8) { const f32x2 v = *(const f32x2*)p; s = v[0] + v[1]; }
            else if constexpr (NSLOT == 16) { const f32x4 v = *(const f32x4*)p; s = (v[0] + v[1]) + (v[2] + v[3]); }
            else { const f32x4 v = *(const f32x4*)p, w = *(const f32x4*)(p + 4); s = ((v[0] + v[1]) + (v[2] + v[3])) + ((w[0] + w[1]) + (w[2] + w[3])); }
            s = fqsum(s); rs[ai][m] = 1.0f / sqrtf(s * inv_n + EPS); }
}
#define EPI_ROWS _Pragma("unroll") for (int ai = 0; ai < 2; ++ai) _Pragma("unroll") for (int m = 0; m < 4; ++m)
#define EPI_BJ _Pragma("unroll") for (int bj = 0; bj < 2; ++bj)

struct EpiP1 {
    static constexpr bool PERM = true, AFTER_DRAIN = false;
    bf16* QKVL; bf16* U; bf16* GV; bf16* G; bf16* KPE; float* QSS; float* KVSS; float* VSS; const float* b_gate; const float* COS; const float* SIN;
    __device__ __forceinline__ void operator()(const f32x4 (&acc)[2][2][4][2], const Unit& u, int wr, int wc, int fr, int fq) const {
        const int row0 = u.pm * 256 + wr * 64 + fr, pn = u.pn, cw = wc * 32 + 8 * fq;
        if (pn < 4) {
            float* SS = (pn < 2) ? QSS : KVSS; const int slot = (pn & 1) * 4 + wc;
            EPI_ROWS { const int row = row0 + ai * 128 + m * 16; float ss = 0.f;
                EPI_BJ { const f32x4 v0 = acc[ai][bj][m][0], v1 = acc[ai][bj][m][1]; ss += sq4(v0) + sq4(v1);
                    *(u32x4*)(QKVL + (size_t)row * 1024 + pn * 256 + bj * 128 + cw) = pack8(v0, v1); }
                ss = fqsum(ss); if (fq == 0) SS[(size_t)row * 8 + slot] = ss; }
        } else if (pn < 12) {
            const bool isv = pn >= 8; bf16* O = isv ? GV : U; const int ct = (pn - (isv ? 8 : 4)) * 256;
            EPI_ROWS { const int row = row0 + ai * 128 + m * 16; float ss = 0.f;
                EPI_BJ { const f32x4 v0 = gelu4(acc[ai][bj][m][0]), v1 = gelu4(acc[ai][bj][m][1]); ss += sq4(v0) + sq4(v1);
                    *(u32x4*)(O + (size_t)row * 1024 + ct + bj * 128 + cw) = pack8(v0, v1); }
                if (isv) { ss = fqsum(ss); if (fq == 0) VSS[(size_t)row * 16 + (pn - 8) * 4 + wc] = ss; } }
        } else if (pn < 28) {
            const int ct = (pn - 12) * 256; f32x4 bv[2][2];
            EPI_BJ { bv[bj][0] = *(const f32x4*)(b_gate + ct + bj * 128 + cw); bv[bj][1] = *(const f32x4*)(b_gate + ct + bj * 128 + cw + 4); }
            EPI_ROWS { const int row = row0 + ai * 128 + m * 16;
                EPI_BJ { const f32x4 v0 = sigm4(acc[ai][bj][m][0] + bv[bj][0]), v1 = sigm4(acc[ai][bj][m][1] + bv[bj][1]);
                    *(u32x4*)(G + (size_t)row * 4096 + ct + bj * 128 + cw) = pack8(v0, v1); } }
        } else {
            if (wc < 2) { const int j4 = 4 * (4 * wc + fq);
                EPI_ROWS { const int row = row0 + ai * 128 + m * 16;
                    const f32x4 c = *(const f32x4*)(COS + (size_t)row * 32 + j4), s = *(const f32x4*)(SIN + (size_t)row * 32 + j4);
                    const f32x4 x1 = acc[ai][0][m][0], x2 = acc[ai][0][m][1];
                    *(u32x2*)(KPE + (size_t)row * 64 + j4) = pack4(x1 * c - x2 * s); *(u32x2*)(KPE + (size_t)row * 64 + 32 + j4) = pack4(x2 * c + x1 * s); } }
        }
    }
};
struct EpiP2 {
    static constexpr bool PERM = true, AFTER_DRAIN = false;
    bf16* Q; bf16* KN; bf16* V; const float* QSS; const float* KVSS; const float* COS; const float* SIN;
    __device__ __forceinline__ void operator()(const f32x4 (&acc)[2][2][4][2], const Unit& u, int wr, int wc, int fr, int fq) const {
        const int row0 = u.pm * 256 + wr * 64 + fr, pn = u.pn, cw = wc * 32 + 8 * fq;
        float rs[2][4]; row_scales<8>(pn < 12 ? QSS : KVSS, row0, fq, 1.0f / 512.0f, rs);
        if (pn < 8) {
            EPI_ROWS { const int row = row0 + ai * 128 + m * 16; const float sc = rs[ai][m] * QSCALE;
                EPI_BJ { *(u32x4*)(Q + (size_t)row * 3072 + (2 * pn + bj) * DQK + cw) = pack8(acc[ai][bj][m][0] * sc, acc[ai][bj][m][1] * sc); } }
        } else if (pn < 12) {
            EPI_ROWS { const int row = row0 + ai * 128 + m * 16; const float sc = rs[ai][m] * QSCALE;
                EPI_BJ { const int cc = bj * 128 + cw, h = 4 * (pn - 8) + (cc >> 6), j4 = (cc & 63) >> 1;
                    const f32x4 c = *(const f32x4*)(COS + (size_t)row * 32 + j4), s = *(const f32x4*)(SIN + (size_t)row * 32 + j4);
                    const f32x4 x1 = acc[ai][bj][m][0] * sc, x2 = acc[ai][bj][m][1] * sc; bf16* q = Q + (size_t)row * 3072 + h * DQK + 128 + j4;
                    *(u32x2*)q = pack4(x1 * c - x2 * s); *(u32x2*)(q + 32) = pack4(x2 * c + x1 * s); } }
        } else {
            const int h = pn - 12;
            EPI_ROWS { const int row = row0 + ai * 128 + m * 16; const float sc = rs[ai][m];
                *(u32x4*)(KN + (size_t)row * 2048 + h * 128 + cw) = pack8(acc[ai][0][m][0] * sc, acc[ai][0][m][1] * sc);
                *(u32x4*)(V + (size_t)row * 2048 + h * 128 + cw) = pack8(acc[ai][1][m][0] * sc, acc[ai][1][m][1] * sc); }
        }
    }
};
struct EpiYs {
    static constexpr bool PERM = true, AFTER_DRAIN = false;
    bf16* YS; const bf16* G;
    __device__ __forceinline__ void operator()(const f32x4 (&acc)[2][2][4][2], const Unit& u, int wr, int wc, int fr, int fq) const {
        const int row0 = u.pm * 256 + wr * 64 + fr, col0 = u.pn * 256 + wc * 32 + 8 * fq;
        EPI_ROWS { const int row = row0 + ai * 128 + m * 16;
            EPI_BJ { const int col = col0 + bj * 128; f32x4 g0, g1; unpack8(*(const u32x4*)(G + (size_t)row * 4096 + 2048 + col), g0, g1);
                *(u32x4*)(YS + (size_t)row * 2048 + col) = pack8(acc[ai][bj][m][0] * g0, acc[ai][bj][m][1] * g1); } }
    }
};
struct EpiMg {
    static constexpr bool PERM = true, AFTER_DRAIN = false;
    bf16* MG; const bf16* G; const bf16* YS;
    __device__ __forceinline__ void operator()(const f32x4 (&acc)[2][2][4][2], const Unit& u, int wr, int wc, int fr, int fq) const {
        const int row0 = u.pm * 256 + wr * 64 + fr, col0 = u.pn * 256 + wc * 32 + 8 * fq;
        EPI_ROWS { const int row = row0 + ai * 128 + m * 16;
            EPI_BJ { const int col = col0 + bj * 128; f32x4 g0, g1, y0, y1; unpack8(*(const u32x4*)(G + (size_t)row * 4096 + col), g0, g1); unpack8(*(const u32x4*)(YS + (size_t)row * 2048 + col), y0, y1);
                *(u32x4*)(MG + (size_t)row * 2048 + col) = pack8(acc[ai][bj][m][0] * g0 + y0, acc[ai][bj][m][1] * g1 + y1); } }
    }
};
struct EpiH1 {
    static constexpr bool PERM = true, AFTER_DRAIN = false;
    const float* x; float* H1; bf16* H1B; float* H1SS;
    __device__ __forceinline__ void operator()(const f32x4 (&acc)[2][2][4][2], const Unit& u, int wr, int wc, int fr, int fq) const {
        const int row0 = u.pm * 256 + wr * 64 + fr, col0 = u.pn * 256 + wc * 32 + 8 * fq;
        EPI_ROWS { const int row = row0 + ai * 128 + m * 16; float ss = 0.f;
            EPI_BJ { const size_t o = (size_t)row * 2048 + col0 + bj * 128;
                const f32x4 h0 = *(const f32x4*)(x + o) + acc[ai][bj][m][0], h1 = *(const f32x4*)(x + o + 4) + acc[ai][bj][m][1]; ss += sq4(h0) + sq4(h1);
                *(f32x4*)(H1 + o) = h0; *(f32x4*)(H1 + o + 4) = h1; *(u32x4*)(H1B + o) = pack8(h0, h1); }
            ss = fqsum(ss); if (fq == 0) H1SS[(size_t)row * 32 + u.pn * 4 + wc] = ss; }
    }
};
struct EpiAct {
    static constexpr bool PERM = true, AFTER_DRAIN = false;
    bf16* ACT; const float* H1SS;
    __device__ __forceinline__ void operator()(const f32x4 (&acc)[2][2][4][2], const Unit& u, int wr, int wc, int fr, int fq) const {
        const int row0 = u.pm * 256 + wr * 64 + fr, col0 = u.pn * 128 + wc * 32 + 8 * fq;
        float rs[2][4]; row_scales<32>(H1SS, row0, fq, 1.0f / 2048.0f, rs);
        EPI_ROWS { const int row = row0 + ai * 128 + m * 16; const float r = rs[ai][m]; f32x4 o[2];
#pragma unroll
            for (int n = 0; n < 2; ++n) { const f32x4 g = acc[ai][0][m][n] * r, up = acc[ai][1][m][n] * r; o[n] = g * sigm4(g) * up; }
            *(u32x4*)(ACT + (size_t)row * DFF + col0) = pack8(o[0], o[1]); }
    }
};
struct EpiH2 {
    static constexpr bool PERM = true, AFTER_DRAIN = false;
    float* H; float* H2SS;
    __device__ __forceinline__ void operator()(const f32x4 (&acc)[2][2][4][2], const Unit& u, int wr, int wc, int fr, int fq) const {
        const int row0 = u.pm * 256 + wr * 64 + fr, col0 = u.pn * 256 + wc * 32 + 8 * fq;
        EPI_ROWS { const int row = row0 + ai * 128 + m * 16; float ss = 0.f;
            EPI_BJ { const size_t o = (size_t)row * 2048 + col0 + bj * 128;
                const f32x4 h0 = *(const f32x4*)(H + o) + acc[ai][bj][m][0], h1 = *(const f32x4*)(H + o + 4) + acc[ai][bj][m][1]; ss += sq4(h0) + sq4(h1);
                *(f32x4*)(H + o) = h0; *(f32x4*)(H + o + 4) = h1; }
            ss = fqsum(ss); if (fq == 0) H2SS[(size_t)row * 32 + u.pn * 4 + wc] = ss; }
    }
};
}

#define LAS __attribute__((address_space(3)))
#define GAS __attribute__((address_space(1)))
namespace sgu {
using pg8::f32x4; using pg8::u32x4; using pg8::u32x2; using pg8::bf16x8;
constexpr int TP = 136;
constexpr int LDS_T = 0, LDS_W = 128 * TP * 2, LDS_R = 2 * 128 * TP * 2, LDS_BYTES = LDS_R + 512;
__device__ __forceinline__ void sgu_unit(LAS unsigned char* lds, int unit, const bf16* U, const bf16* GV, const float* VSS, const float* gn, const float* ws, const float* bs, bf16* SG) {
    const int tid = threadIdx.x, lane = tid & 63, wid = __builtin_amdgcn_readfirstlane(tid >> 6), fr = lane & 15, fq = lane >> 4;
    const int g = unit & 7, m0 = (unit >> 3) * 128, c0 = g * 128;
    LAS bf16* T = (LAS bf16*)(lds + LDS_T); LAS bf16* WSL = (LAS bf16*)(lds + LDS_W); LAS float* rvs = (LAS float*)(lds + LDS_R);
    if (tid < 128) { const f32x4* p = (const f32x4*)(VSS + (size_t)(m0 + tid) * 16); float s = 0.f;
#pragma unroll
        for (int i = 0; i < 4; ++i) { const f32x4 v = p[i]; s += (v[0] + v[1]) + (v[2] + v[3]); }
        rvs[tid] = 1.0f / sqrtf(s * (1.0f / 1024.0f) + EPS); }
    __syncthreads();
#pragma unroll
    for (int i = 0; i < 4; ++i) { const int idx = tid + 512 * i, s = idx >> 4, dc = (idx & 15) * 8;
        f32x4 v0, v1; epi::unpack8(*(const u32x4*)(GV + (size_t)(m0 + s) * SGW + c0 + dc), v0, v1);
        const f32x4 g0 = *(const f32x4*)(gn + c0 + dc), g1 = *(const f32x4*)(gn + c0 + dc + 4); const float r = rvs[s];
        v0 = v0 * r * g0; v1 = v1 * r * g1;
#pragma unroll
        for (int e = 0; e < 4; ++e) { T[(dc + e) * TP + s] = f2bf(v0[e]); T[(dc + 4 + e) * TP + s] = f2bf(v1[e]); } }
#pragma unroll
    for (int i = 0; i < 8; ++i) { const int idx = tid + 512 * i, t = idx >> 5, s4 = (idx & 31) * 4;
        f32x4 w = *(const f32x4*)(ws + (size_t)(g * CHUNK + t) * CHUNK + s4);
#pragma unroll
        for (int e = 0; e < 4; ++e) w[e] = (s4 + e <= t) ? w[e] : 0.f;
        *(LAS u32x2*)(WSL + t * TP + s4) = epi::pack4(w); }
    __syncthreads();
    f32x4 acc[8];
#pragma unroll
    for (int nt = 0; nt < 8; ++nt) acc[nt] = (f32x4){0.f, 0.f, 0.f, 0.f};
#pragma unroll
    for (int ks = 0; ks < 4; ++ks) {
        if (32 * ks <= 16 * wid + 15) {
            const bf16x8 bw = *(const LAS bf16x8*)(WSL + (16 * wid + fr) * TP + 32 * ks + 8 * fq);
#pragma unroll
            for (int nt = 0; nt < 8; ++nt) { const bf16x8 at = *(const LAS bf16x8*)(T + (16 * nt + fr) * TP + 32 * ks + 8 * fq);
                acc[nt] = __builtin_amdgcn_mfma_f32_16x16x32_bf16(at, bw, acc[nt], 0, 0, 0); } }
    }
    const int t = 16 * wid + fr; const float bt = bs[g * CHUNK + t]; const size_t ro = (size_t)(m0 + t) * SGW + c0 + 4 * fq;
#pragma unroll
    for (int nt = 0; nt < 8; ++nt) { const u32x2 uw = *(const u32x2*)(U + ro + 16 * nt); f32x4 uu;
        uu[0] = __uint_as_float(uw.x << 16); uu[1] = __uint_as_float(uw.x & 0xffff0000u); uu[2] = __uint_as_float(uw.y << 16); uu[3] = __uint_as_float(uw.y & 0xffff0000u);
        *(u32x2*)(SG + ro + 16 * nt) = epi::pack4(uu * (acc[nt] + bt)); }
    __syncthreads();
}
}

namespace att {
typedef short bf16x8 __attribute__((ext_vector_type(8)));
typedef short s16x4 __attribute__((ext_vector_type(4)));
typedef float f32x16 __attribute__((ext_vector_type(16)));
typedef float f32x4 __attribute__((ext_vector_type(4)));
constexpr int KSLOT = 24576, VSLOT = 16384, SLOT = KSLOT + VSLOT, NSLOT = 2, LDS_BYTES = NSLOT * SLOT;
__device__ __forceinline__ void glds16(const void* gsrc, unsigned lds_dst) { unsigned keep;
    asm volatile("s_mov_b32 %0, m0\n\ts_mov_b32 m0, %2\n\ts_nop 0\n\tglobal_load_lds_dwordx4 %1, off\n\ts_mov_b32 m0, %0" : "=&s"(keep) : "v"(gsrc), "s"(lds_dst) : "memory"); }
__device__ __forceinline__ s16x4 vtr(const LAS char* p) { typedef short v4i16_t __attribute__((ext_vector_type(4))); return __builtin_bit_cast(s16x4, __builtin_amdgcn_ds_read_tr16_b64_v4i16((LAS v4i16_t*)p)); }
__device__ __forceinline__ bf16x8 pack8(const f32x16& p, int b) { pg8::u32x4 w; w.x = epi::cvtpk(p[b], p[b + 1]); w.y = epi::cvtpk(p[b + 2], p[b + 3]); w.z = epi::cvtpk(p[b + 4], p[b + 5]); w.w = epi::cvtpk(p[b + 6], p[b + 7]); return __builtin_bit_cast(bf16x8, w); }
__device__ __forceinline__ float xhalf_max(float v) { auto rr = __builtin_amdgcn_permlane32_swap(__float_as_uint(v), __float_as_uint(v), false, false); return fmaxf(__uint_as_float(rr[0]), __uint_as_float(rr[1])); }
__device__ __forceinline__ float xhalf_sum(float v) { auto rr = __builtin_amdgcn_permlane32_swap(__float_as_uint(v), __float_as_uint(v), false, false); return __uint_as_float(rr[0]) + __uint_as_float(rr[1]); }

__device__ __forceinline__ void attn_unit(LAS unsigned char* lds, int b, int h, int qb, const bf16* Q, const bf16* KN, const bf16* KPE, const bf16* V, bf16* AO) {
    const int tid = threadIdx.x, lane = tid & 63, r32 = lane & 31, hi = lane >> 5; const int wid = __builtin_amdgcn_readfirstlane(tid >> 6);
    const size_t rowbase = (size_t)b * SEQ; const int q0 = qb * 256;
    const unsigned lds0 = (unsigned)(uintptr_t)lds;
    const bf16* ksrc0 = KN + (rowbase + lane) * 2048 + h * 128 + wid * 8;
    const bf16* ksrc2 = KPE + (rowbase + lane) * 64 + wid * 8;
    const bf16* vsrc0 = V + (rowbase + 16 * (wid & 3) + (lane >> 2)) * 2048 + h * 128 + 32 * (wid >> 2) + (lane & 3) * 8;
    const unsigned kd = lds0 + (unsigned)wid * 1024u;
#define ATT_DMA_TILE(t, so) do { const size_t ko_ = (size_t)(t) * 64 * 2048, po_ = (size_t)(t) * 64 * 64; const unsigned d_ = (unsigned)__builtin_amdgcn_readfirstlane(kd + (so)); \
        glds16(ksrc0 + ko_, d_); glds16(ksrc0 + ko_ + 64, d_ + 8192u); glds16(ksrc2 + po_, d_ + 16384u); \
        glds16(vsrc0 + ko_, d_ + KSLOT); glds16(vsrc0 + ko_ + 64, d_ + KSLOT + 8192u); } while (0)
    const int NT = 4 * (qb + 1);
    ATT_DMA_TILE(0, 0);
    const bf16* Qw = Q + (rowbase + q0 + wid * 32 + r32) * 3072 + h * DQK + hi * 8;
    bf16x8 qr[12];
#pragma unroll
    for (int ks = 0; ks < 12; ++ks) qr[ks] = *(const bf16x8*)(Qw + ks * 16);
#pragma unroll
    for (int ks = 0; ks < 12; ++ks) asm volatile("" : "+v"(qr[ks]));
    float mrow = -1e30f, lsum = 0.f; f32x16 oT[4];
#pragma unroll
    for (int d = 0; d < 4; ++d)
#pragma unroll
        for (int r = 0; r < 16; ++r) oT[d][r] = 0.f;
    const int qrel = wid * 32 + r32;
    for (int t = 0; t < NT; ++t) {
        const int so = (t & 1) * SLOT;
        asm volatile("s_waitcnt vmcnt(0) lgkmcnt(0)\n\ts_barrier" ::: "memory");
        if (t + 1 < NT) ATT_DMA_TILE(t + 1, ((t + 1) & 1) * SLOT);
        const int jb = t - 4 * qb;
        if (!(jb >= 0 && 64 * jb > 32 * wid + 31)) {
            f32x16 p0, p1;
#pragma unroll
            for (int r = 0; r < 16; ++r) { p0[r] = 0.f; p1[r] = 0.f; }
            const LAS char* kb = (const LAS char*)lds + so + hi * 1024 + r32 * 16;
#pragma unroll
            for (int ks = 0; ks < 12; ++ks) { const bf16x8 a0 = *(const LAS bf16x8*)(kb + ks * 2048), a1 = *(const LAS bf16x8*)(kb + ks * 2048 + 512);
                p0 = __builtin_amdgcn_mfma_f32_32x32x16_bf16(a0, qr[ks], p0, 0, 0, 0); p1 = __builtin_amdgcn_mfma_f32_32x32x16_bf16(a1, qr[ks], p1, 0, 0, 0); }
            if (jb >= 0) { const int kb0 = 64 * jb + 4 * hi; const float NEG = -__builtin_inff();
#pragma unroll
                for (int r = 0; r < 16; ++r) { const int kv = kb0 + (r & 3) + 8 * (r >> 2); if (kv > qrel) p0[r] = NEG; if (kv + 32 > qrel) p1[r] = NEG; } }
            float mx = fmaxf(p0[0], p1[0]);
#pragma unroll
            for (int r = 1; r < 16; ++r) mx = fmaxf(mx, fmaxf(p0[r], p1[r]));
            mx = xhalf_max(mx);
            const float mnew = fmaxf(mrow, mx), alpha = __builtin_amdgcn_exp2f(mrow - mnew); mrow = mnew;
            float ps = 0.f;
#pragma unroll
            for (int r = 0; r < 16; ++r) { p0[r] = __builtin_amdgcn_exp2f(p0[r] - mnew); p1[r] = __builtin_amdgcn_exp2f(p1[r] - mnew); ps += p0[r] + p1[r]; }
            lsum = lsum * alpha + ps;
            if (!__all(alpha == 1.0f)) {
#pragma unroll
                for (int d = 0; d < 4; ++d)
#pragma unroll
                    for (int r = 0; r < 16; ++r) oT[d][r] *= alpha; }
            const bf16x8 pb0 = pack8(p0, 0), pb1 = pack8(p0, 8), pb2 = pack8(p1, 0), pb3 = pack8(p1, 8);
            const LAS char* vb = (const LAS char*)lds + so + KSLOT + ((lane >> 4) & 1) * 32 + (lane & 3) * 8 + (4 * hi + ((lane & 15) >> 2)) * 64;
#pragma unroll
            for (int d = 0; d < 4; ++d) {
#define ATT_PV(s, PB) do { const s16x4 lo_ = vtr(vb + d * 4096 + (s) * 1024), hi_ = vtr(vb + d * 4096 + (s) * 1024 + 512); \
                const bf16x8 vf_ = (bf16x8){lo_[0], lo_[1], lo_[2], lo_[3], hi_[0], hi_[1], hi_[2], hi_[3]}; oT[d] = __builtin_amdgcn_mfma_f32_32x32x16_bf16(vf_, PB, oT[d], 0, 0, 0); } while (0)
                ATT_PV(0, pb0); ATT_PV(1, pb1); ATT_PV(2, pb2); ATT_PV(3, pb3);
#undef ATT_PV
            }
        }
    }
    const float inv = 1.0f / xhalf_sum(lsum);
    bf16* Ow = AO + (rowbase + q0 + wid * 32 + r32) * 2048 + h * 128 + 4 * hi;
#pragma unroll
    for (int d = 0; d < 4; ++d)
#pragma unroll
        for (int g = 0; g < 4; ++g) { f32x4 v = {oT[d][4 * g] * inv, oT[d][4 * g + 1] * inv, oT[d][4 * g + 2] * inv, oT[d][4 * g + 3] * inv};
            *(pg8::u32x2*)(Ow + 32 * d + 8 * g) = epi::pack4(v); }
#undef ATT_DMA_TILE
}
}

#define XB_TMO      128
#define XB_XCNT(j)  (256  + 64 * (j))
#define XB_XSUB(j)  (1280 + 64 * (j))
#define XB_XGEN(j)  (2304 + 64 * (j))
#define XB_TOP      3328
#define XB_TOPGEN   3392
#define XCD_BAR_WORDS 3456
#define XB_SPIN_CAP (1u << 18)
__device__ __forceinline__ unsigned xb_ld(unsigned* p)              { return __hip_atomic_load(p, __ATOMIC_RELAXED, __HIP_MEMORY_SCOPE_AGENT); }
__device__ __forceinline__ unsigned xb_add(unsigned* p, unsigned v) { return __hip_atomic_fetch_add(p, v, __ATOMIC_RELAXED, __HIP_MEMORY_SCOPE_AGENT); }
__device__ __forceinline__ unsigned xb_xcc_id() { return (unsigned)__builtin_amdgcn_s_getreg((3 << 11) | 20) & 0xFu; }
#define XB_SPIN(cond, bar) do { unsigned _sp = 0; while (cond) { __builtin_amdgcn_s_sleep(1); \
    if ((++_sp & 255u) == 0u) { if (xb_ld(&(bar)[XB_TMO])) break; if (_sp > XB_SPIN_CAP) { atomicAdd(&(bar)[XB_TMO], 1u); break; } } } } while (0)
struct XcdBarrier { unsigned* bar; unsigned x; volatile LAS unsigned* st; };
__device__ __forceinline__ XcdBarrier xcd_barrier_post(unsigned* bar, volatile LAS unsigned* st) {
    XcdBarrier b; b.bar = bar; b.x = xb_xcc_id(); b.st = st;
    if (threadIdx.x == 0) (void)xb_add(&bar[XB_XCNT(b.x)], 1u);
    return b;
}
__device__ __forceinline__ void xcd_barrier_complete(unsigned* bar, unsigned x, unsigned& nloc, unsigned& nx) {
    const unsigned G = gridDim.x * gridDim.y * gridDim.z;
    unsigned sum, cnt, mine, sp = 0u;
    for (;;) {
        sum = 0u; cnt = 0u; mine = 0u;
#pragma unroll
        for (unsigned j = 0; j < 16; ++j) { const unsigned c = xb_ld(&bar[XB_XCNT(j)]); sum += c; cnt += (c > 0u) ? 1u : 0u; mine = (j == x) ? c : mine; }
        if (sum == G) break;
        __builtin_amdgcn_s_sleep(1);
        if ((++sp & 255u) == 0u) { if (xb_ld(&bar[XB_TMO])) break; if (sp > XB_SPIN_CAP) { atomicAdd(&bar[XB_TMO], 1u); break; } }
    }
    nloc = mine > 0u ? mine : 1u; nx = cnt > 0u ? cnt : 1u;
}
__device__ __forceinline__ void xcd_barrier(const XcdBarrier& b) {
    asm volatile("s_waitcnt vmcnt(0)" ::: "memory");
    __syncthreads();
    if (threadIdx.x == 0) {
        unsigned* bar = b.bar;
        __builtin_amdgcn_s_waitcnt(0);
        unsigned nloc = b.st[0], nx = b.st[1];
        if (nloc == 0u) { xcd_barrier_complete(bar, b.x, nloc, nx); b.st[0] = nloc; b.st[1] = nx; }
        const unsigned old = xb_add(&bar[XB_XSUB(b.x)], 1u);
        const unsigned gen = old / nloc;
        if (old + 1u == (gen + 1u) * nloc) {
            __builtin_amdgcn_fence(__ATOMIC_RELEASE, "agent");
            asm volatile("s_waitcnt vmcnt(0)" ::: "memory");
            const unsigned og = xb_add(&bar[XB_TOP], 1u);
            const unsigned tg = og / nx;
            if (og + 1u == (tg + 1u) * nx) xb_add(&bar[XB_TOPGEN], 1u);
            else XB_SPIN(xb_ld(&bar[XB_TOPGEN]) == tg, bar);
            __builtin_amdgcn_fence(__ATOMIC_ACQUIRE, "agent");
            xb_add(&bar[XB_XGEN(b.x)], 1u);
            asm volatile("s_waitcnt vmcnt(0)" ::: "memory");
        } else {
            XB_SPIN(xb_ld(&bar[XB_XGEN(b.x)]) == gen, bar);
            __builtin_amdgcn_fence(__ATOMIC_ACQUIRE, "agent");
            asm volatile("s_waitcnt vmcnt(0)" ::: "memory");
        }
    }
    __syncthreads();
}

constexpr int NWAVES = 8;
constexpr int RING_OFF = 0, RING_BYTES = 131072;
constexpr int LDSCTL_OFF = RING_BYTES, MISC_OFF = LDSCTL_OFF + 320;
constexpr int LDS_BYTES = 147456;
constexpr int CW_BAR = 4096;
static_assert((CW_BAR + XCD_BAR_WORDS) * 4 <= (int)CTL_ZERO_BYTES, "barrier words inside the memset region");
static_assert(att::LDS_BYTES <= RING_BYTES && sgu::LDS_BYTES <= RING_BYTES && NWAVES * 64 * 33 * 4 <= RING_BYTES, "phase scratch fits the ring");
#define LDS_WAIT() asm volatile("s_waitcnt lgkmcnt(0)" ::: "memory")
#define WG_DRAIN_BAR() asm volatile("s_waitcnt vmcnt(0) lgkmcnt(0)\n\ts_barrier" ::: "memory")

__device__ __forceinline__ int pairpos(int p) { const int i = p & 31; return 8 * (i >> 2) + (i & 3) + ((p >> 5) << 2); }
template <int MAP> __device__ __forceinline__ int dest_row(int n) {
    if constexpr (MAP == 1) { return n < 1024 ? n : (n < 1088 ? 7168 + pairpos(n - 1024) : n - 64); }
    else if constexpr (MAP == 2) { const int h = n / DQK, d = n - h * DQK; return d < 128 ? h * 128 + d : 2048 + h * 64 + pairpos(d - 128); }
    else if constexpr (MAP == 3) { return (n >> 7) * 256 + (n & 127); }
    else if constexpr (MAP == 4) { return (n >> 7) * 256 + 128 + (n & 127); }
    else return n;
}
template <int MAP> __device__ __forceinline__ void cvt_item(const float* W, int ldw, int K, int nblk, const float* ksc, bf16* WT, int row_off, LAS float* scr, int item, int lane) {
    const int kb = item / nblk, nb = item - kb * nblk, k0 = 64 * kb, n0 = 32 * nb;
#pragma unroll 8
    for (int i = 0; i < 32; ++i) { const int kk = 2 * i + (lane >> 5); float v = W[(size_t)(k0 + kk) * ldw + n0 + (lane & 31)]; if (ksc) v *= ksc[k0 + kk]; scr[kk * 33 + (lane & 31)] = v; }
    LDS_WAIT(); asm volatile("" ::: "memory");
    const int c = lane & 7;
#pragma unroll
    for (int j = 0; j < 4; ++j) { const int n = (lane >> 3) + 8 * j; const LAS float* s = scr + (8 * c) * 33 + n;
        pg8::u32x4 o; o.x = epi::cvtpk(s[0 * 33], s[1 * 33]); o.y = epi::cvtpk(s[2 * 33], s[3 * 33]); o.z = epi::cvtpk(s[4 * 33], s[5 * 33]); o.w = epi::cvtpk(s[6 * 33], s[7 * 33]);
        *(pg8::u32x4*)(WT + (size_t)(row_off + dest_row<MAP>(n0 + n)) * K + k0 + 8 * c) = o; }
    LDS_WAIT(); asm volatile("" ::: "memory");
}

struct Args { const void* in[20]; float* out; unsigned char* ws; int ph_lo, ph_hi; };

__global__ void __launch_bounds__(NWAVES * 64, 2) mega_fwd(Args args) {
    extern __shared__ __attribute__((aligned(16))) unsigned char lds_raw[];
    LAS unsigned char* lds = (LAS unsigned char*)lds_raw;
    volatile LAS unsigned* MISC = (volatile LAS unsigned*)(lds + MISC_OFF);
    const int tid = threadIdx.x, lane = tid & 63, wave = __builtin_amdgcn_readfirstlane(tid >> 6);
    const int G = gridDim.x, bx = blockIdx.x, vcu = (G % 8 == 0) ? (bx % 8) * (G / 8) + bx / 8 : bx;
    const int gw = vcu * NWAVES + wave, NGW = G * NWAVES;
    unsigned char* ws = args.ws;
    const float* x = (const float*)args.in[0]; const int* pos = (const int*)args.in[1]; const float* g_mix = (const float*)args.in[2]; const float* w_in = (const float*)args.in[3];
    const float* b_gate = (const float*)args.in[4]; const float* g_q = (const float*)args.in[5]; const float* w_uq = (const float*)args.in[6]; const float* g_kv = (const float*)args.in[7];
    const float* w_ukv = (const float*)args.in[8]; const float* w_oa = (const float*)args.in[9]; const float* g_sgu = (const float*)args.in[10]; const float* w_sgu = (const float*)args.in[11];
    const float* b_sgu = (const float*)args.in[12]; const float* w_os = (const float*)args.in[13]; const float* w_out = (const float*)args.in[14]; const float* g_ffn = (const float*)args.in[15];
    const float* w_g = (const float*)args.in[16]; const float* w_u = (const float*)args.in[17]; const float* w_d = (const float*)args.in[18]; const float* g_fin = (const float*)args.in[19];
    float* COS = (float*)(ws + WS_COS); float* SIN = (float*)(ws + WS_SIN);
    float* QSS = (float*)(ws + WS_QSS); float* KVSS = (float*)(ws + WS_KVSS); float* VSS = (float*)(ws + WS_VSS); float* H1SS = (float*)(ws + WS_H1SS); float* H2SS = (float*)(ws + WS_H2SS);
    bf16* Win_t = (bf16*)(ws + WS_WIN); bf16* Wqkv_t = (bf16*)(ws + WS_WQKV); bf16* Wosgu_t = (bf16*)(ws + WS_WOSGU); bf16* Woatt_t = (bf16*)(ws + WS_WOATT); bf16* Wout_t = (bf16*)(ws + WS_WOUT);
    bf16* Wgu_t = (bf16*)args.out; bf16* Wdown_t = (bf16*)(ws + WS_WDOWN);
    bf16* XN = (bf16*)(ws + WS_XN); bf16* AO = (bf16*)(ws + WS_AO); bf16* U = (bf16*)(ws + WS_U); bf16* GV = (bf16*)(ws + WS_GV); bf16* YS = (bf16*)(ws + WS_YS);
    bf16* QKVL = (bf16*)(ws + WS_QKVL); bf16* KPE = (bf16*)(ws + WS_KPE); bf16* SG = (bf16*)(ws + WS_SG); bf16* Q = (bf16*)(ws + WS_Q);
    bf16* KN = (bf16*)(ws + WS_KN); bf16* V = (bf16*)(ws + WS_V); bf16* MG = (bf16*)(ws + WS_MG); float* H1 = (float*)(ws + WS_H1); bf16* H1B = (bf16*)(ws + WS_H1B);
    bf16* ACT = (bf16*)(ws + WS_ACT); bf16* Gt = (bf16*)args.out;

    for (int u = tid; u < (LDS_BYTES - LDSCTL_OFF) / 4; u += NWAVES * 64) ((LAS unsigned*)(lds + LDSCTL_OFF))[u] = 0u;
    __syncthreads();
    const int lo = args.ph_lo, hi = args.ph_hi;
    XcdBarrier bar; bar.bar = (unsigned*)(ws + WS_CTL) + CW_BAR; bar.x = 0; bar.st = nullptr;
    if (hi - lo > 1) bar = xcd_barrier_post((unsigned*)(ws + WS_CTL) + CW_BAR, MISC + 8);
#define IN(k) (lo <= (k) && (k) < hi)
#define SEAM(k) do { if (IN(k) && IN((k) + 1)) xcd_barrier(bar); } while (0)

    if (IN(0)) {
        LAS float* scr = (LAS float*)(lds + RING_OFF + wave * 16384);
        constexpr int I_IN = (DM / 64) * (DIN / 32), I_UQ = (QLR / 64) * (3072 / 32), I_UKV = (KVLR / 64) * (4096 / 32), I_OS = (SGW / 64) * (DM / 32), I_OA = (DM / 64) * (DM / 32), I_OUT = I_OA;
        constexpr int NITEMS = I_IN + I_UQ + I_UKV + I_OS + I_OA + I_OUT;
        for (int it = gw; it < NITEMS; it += NGW) {
            int r = it;
            if (r < I_IN) { cvt_item<1>(w_in, DIN, DM, DIN / 32, nullptr, Win_t, 0, scr, r, lane); continue; } r -= I_IN;
            if (r < I_UQ) { cvt_item<2>(w_uq, 3072, QLR, 3072 / 32, g_q, Wqkv_t, 0, scr, r, lane); continue; } r -= I_UQ;
            if (r < I_UKV) { cvt_item<0>(w_ukv, 4096, KVLR, 4096 / 32, g_kv, Wqkv_t, 3072, scr, r, lane); continue; } r -= I_UKV;
            if (r < I_OS) { cvt_item<0>(w_os, DM, SGW, DM / 32, nullptr, Wosgu_t, 0, scr, r, lane); continue; } r -= I_OS;
            if (r < I_OA) { cvt_item<0>(w_oa, DM, DM, DM / 32, nullptr, Woatt_t, 0, scr, r, lane); continue; } r -= I_OA;
            cvt_item<0>(w_out, DM, DM, DM / 32, nullptr, Wout_t, 0, scr, r, lane);
        }
        { pg8::u32x4* pad = (pg8::u32x4*)(Win_t + (size_t)DIN * DM); const int npad = (NIN_T - DIN) * DM * 2 / 16;
          for (int i = vcu * 512 + tid; i < npad; i += G * 512) pad[i] = (pg8::u32x4){0u, 0u, 0u, 0u}; }
        for (int idx = vcu * 512 + tid; idx < M * 32; idx += G * 512) { const int m = idx >> 5, i = idx & 31;
            const float inv = powf(10000.0f, -(float)(2 * i) / 64.0f); const float ang = (float)pos[m] * inv; COS[idx] = cosf(ang); SIN[idx] = sinf(ang); }
        for (int m = gw; m < M; m += NGW) {
            const pg8::f32x4* xr = (const pg8::f32x4*)(x + (size_t)m * DM) + lane; pg8::f32x4 v[8]; float s = 0.f;
#pragma unroll
            for (int j = 0; j < 8; ++j) { v[j] = xr[64 * j]; s += epi::sq4(v[j]); }
            const float r = 1.0f / sqrtf(wave_sum(s) * (1.0f / DM) + EPS);
            pg8::u32x2* o8 = (pg8::u32x2*)(XN + (size_t)m * DM) + lane;
#pragma unroll
            for (int j = 0; j < 8; ++j) { const pg8::f32x4 gg = *((const pg8::f32x4*)g_mix + lane + 64 * j); o8[64 * j] = epi::pack4(v[j] * r * gg); }
        }
    }
    SEAM(0);
    if (IN(1)) {
        pg8::Gemm g{XN, Win_t, DM, DM, DM}; pg8::StaticOrder S; S.init(M, NIN_T, G, bx);
        epi::EpiP1 E{QKVL, U, GV, Gt, KPE, QSS, KVSS, VSS, b_gate, COS, SIN};
        pg8::gemm_phase<epi::EpiP1, pg8::StaticOrder, true, true>(lds + RING_OFF, g, S, E);
    }
    SEAM(1);
    if (IN(2)) {
        pg8::Gemm g{QKVL, Wqkv_t, 1024, 512, 512}; pg8::StaticOrder S; S.init(M, 7168, G, bx, 12, 512);
        epi::EpiP2 E{Q, KN, V, QSS, KVSS, COS, SIN};
        pg8::gemm_phase<epi::EpiP2, pg8::StaticOrder, true, true>(lds + RING_OFF, g, S, E);
        for (int u = vcu; u < BATCH * (SEQ / CHUNK) * SGG; u += G) sgu::sgu_unit(lds + RING_OFF, u, U, GV, VSS, g_sgu, w_sgu, b_sgu, SG);
    }
    SEAM(2);
    if (IN(3)) {
        for (int p = vcu; p < BATCH * NH * 4; p += G) { const int bh = p >> 2, s = p & 3;
            att::attn_unit(lds + RING_OFF, bh / NH, bh % NH, s, Q, KN, KPE, V, AO);
            att::attn_unit(lds + RING_OFF, bh / NH, bh % NH, 7 - s, Q, KN, KPE, V, AO); }
        WG_DRAIN_BAR();
        pg8::Gemm g{SG, Wosgu_t, SGW, SGW, SGW}; pg8::StaticOrder S; S.init(M, DM, G, bx);
        epi::EpiYs E{YS, Gt};
        pg8::gemm_phase<epi::EpiYs, pg8::StaticOrder, false, true>(lds + RING_OFF, g, S, E);
    }
    SEAM(3);
    if (IN(4)) {
        pg8::Gemm g{AO, Woatt_t, DM, DM, DM}; pg8::StaticOrder S; S.init(M, DM, G, bx);
        epi::EpiMg E{MG, Gt, YS};
        pg8::gemm_phase<epi::EpiMg, pg8::StaticOrder, false, true>(lds + RING_OFF, g, S, E);
    }
    SEAM(4);
    if (IN(5)) {
        LAS float* scr = (LAS float*)(lds + RING_OFF + wave * 16384);
        constexpr int I_G = (DM / 64) * (DFF / 32), I_D = (DFF / 64) * (DM / 32), NITEMS = 2 * I_G + I_D;
        for (int it = gw; it < NITEMS; it += NGW) {
            int r = it;
            if (r < I_G) { cvt_item<3>(w_g, DFF, DM, DFF / 32, g_ffn, Wgu_t, 0, scr, r, lane); continue; } r -= I_G;
            if (r < I_G) { cvt_item<4>(w_u, DFF, DM, DFF / 32, g_ffn, Wgu_t, 0, scr, r, lane); continue; } r -= I_G;
            cvt_item<0>(w_d, DM, DFF, DM / 32, nullptr, Wdown_t, 0, scr, r, lane);
        }
        WG_DRAIN_BAR();
        pg8::Gemm g{MG, Wout_t, DM, DM, DM}; pg8::StaticOrder S; S.init(M, DM, G, bx);
        epi::EpiH1 E{x, H1, H1B, H1SS};
        pg8::gemm_phase<epi::EpiH1, pg8::StaticOrder, false, true>(lds + RING_OFF, g, S, E);
    }
    SEAM(5);
    if (IN(6)) {
        pg8::Gemm g{H1B, Wgu_t, DM, DM, DM}; pg8::StaticOrder S; S.init(M, 2 * DFF, G, bx);
        epi::EpiAct E{ACT, H1SS};
        pg8::gemm_phase<epi::EpiAct, pg8::StaticOrder, true, true>(lds + RING_OFF, g, S, E);
    }
    SEAM(6);
    if (IN(7)) {
        pg8::Gemm g{ACT, Wdown_t, DFF, DFF, DFF}; pg8::StaticOrder S; S.init(M, DM, G, bx);
        epi::EpiH2 E{H1, H2SS};
        pg8::gemm_phase<epi::EpiH2, pg8::StaticOrder, false, true>(lds + RING_OFF, g, S, E);
    }
    SEAM(7);
    if (IN(8)) {
        for (int m = gw; m < M; m += NGW) {
            float s = (lane < 32) ? H2SS[(size_t)m * 32 + lane] : 0.f; s = wave_sum(s);
            const float r = 1.0f / sqrtf(s * (1.0f / DM) + EPS);
            const pg8::f32x4* hr = (const pg8::f32x4*)(H1 + (size_t)m * DM) + lane; pg8::f32x4* o = (pg8::f32x4*)(args.out + (size_t)m * DM) + lane;
#pragma unroll
            for (int j = 0; j < 8; ++j) o[64 * j] = hr[64 * j] * r * *((const pg8::f32x4*)g_fin + lane + 64 * j);
        }
    }
#undef IN
#undef SEAM
}

#ifndef OPTMASK
#define OPTMASK 0x1ff
#endif
template <int NC, class F> static void run_ngemm(hipStream_t st, const bf16* A, int lda, int K, int N, int ldw, const float* ks, F f) {
    hipLaunchKernelGGL((ngemm<NC, F>), dim3((N + 255) / 256, M / 16), dim3(256), 0, st, A, lda, K, N, ldw, ks, f);
}
extern "C" void kernel_launch(void* const* d_in, const int* in_sizes, int n_in, void* d_out, int out_size, void* d_ws, size_t ws_size, hipStream_t stream) {
    static int grid = 0;
    if (grid == 0) {
        if (n_in != 20 || ws_size < WS_END || out_size != M * DM || in_sizes[0] != M * DM) { fprintf(stderr, "kernel_launch: unexpected shapes (n_in %d ws %zu out %d)\n", n_in, ws_size, out_size); grid = -1; return; }
        int dev = 0, cus = 0, per_cu = 0;
        if (hipGetDevice(&dev) != hipSuccess || hipDeviceGetAttribute(&cus, hipDeviceAttributeMultiprocessorCount, dev) != hipSuccess) { grid = -1; return; }
        if (hipFuncSetAttribute((const void*)mega_fwd, hipFuncAttributeMaxDynamicSharedMemorySize, LDS_BYTES) != hipSuccess) { fprintf(stderr, "kernel_launch: hipFuncSetAttribute failed\n"); grid = -1; return; }
        if (hipOccupancyMaxActiveBlocksPerMultiprocessor(&per_cu, (const void*)mega_fwd, NWAVES * 64, LDS_BYTES) != hipSuccess || per_cu < 1) { fprintf(stderr, "kernel_launch: occupancy query says %d blocks per CU\n", per_cu); per_cu = 1; }
        (void)hipGetLastError();
        grid = cus;
        if (grid != 256) fprintf(stderr, "kernel_launch: %d CUs (tuned for 256)\n", grid);
    }
    if (grid < 0) return;
    const float* x = (const float*)d_in[0]; const int* pos = (const int*)d_in[1]; const float* g_mix = (const float*)d_in[2]; const float* w_in = (const float*)d_in[3];
    const float* b_gate = (const float*)d_in[4]; const float* g_q = (const float*)d_in[5]; const float* w_uq = (const float*)d_in[6]; const float* g_kv = (const float*)d_in[7];
    const float* w_ukv = (const float*)d_in[8]; const float* w_oa = (const float*)d_in[9]; const float* g_sgu = (const float*)d_in[10]; const float* w_sgu = (const float*)d_in[11];
    const float* b_sgu = (const float*)d_in[12]; const float* w_os = (const float*)d_in[13]; const float* w_out = (const float*)d_in[14]; const float* g_ffn = (const float*)d_in[15];
    const float* w_g = (const float*)d_in[16]; const float* w_u = (const float*)d_in[17]; const float* w_d = (const float*)d_in[18]; const float* g_fin = (const float*)d_in[19];
    unsigned char* ws = (unsigned char*)d_ws; float* out = (float*)d_out;
    float* COS = (float*)(ws + WS_COS); float* SIN = (float*)(ws + WS_SIN);
    float* RQ = (float*)(ws + WS_RQ); float* RKV = (float*)(ws + WS_RKV); float* RV = (float*)(ws + WS_RV); float* RF = (float*)(ws + WS_RF);
    bf16* XN = (bf16*)(ws + WS_XN); bf16* AO = (bf16*)(ws + WS_AO); bf16* U = (bf16*)(ws + WS_U); bf16* GV = (bf16*)(ws + WS_GV); bf16* YS = (bf16*)(ws + WS_YS);
    bf16* QKVL = (bf16*)(ws + WS_QKVL); bf16* KPE = (bf16*)(ws + WS_KPE); bf16* SG = (bf16*)(ws + WS_SG); bf16* Q = (bf16*)(ws + WS_Q);
    bf16* KN = (bf16*)(ws + WS_KN); bf16* V = (bf16*)(ws + WS_V); bf16* MG = (bf16*)(ws + WS_MG); float* H1 = (float*)(ws + WS_H1); bf16* H1B = (bf16*)(ws + WS_H1B);
    bf16* ACT = (bf16*)(ws + WS_ACT); bf16* G = (bf16*)d_out;
    (void)hipMemsetAsync(ws + WS_CTL, 0, CTL_ZERO_BYTES, stream);
    Args a{};
    for (int i = 0; i < 20; ++i) a.in[i] = d_in[i];
    a.out = out; a.ws = ws;
    for (int p = 0; p < 9;) {
        if ((OPTMASK >> p) & 1) { int q = p; while (q < 9 && ((OPTMASK >> q) & 1)) ++q;
            a.ph_lo = p; a.ph_hi = q; hipLaunchKernelGGL(mega_fwd, dim3(grid), dim3(NWAVES * 64), LDS_BYTES, stream, a);
            const hipError_t le = hipPeekAtLastError(); if (le != hipSuccess) fprintf(stderr, "kernel_launch: launch [%d,%d) failed: %s\n", p, q, hipGetErrorName(le));
            p = q; continue; }
        switch (p) {
        case 0: hipLaunchKernelGGL(k_rope_tab, dim3(M * 32 / 256), dim3(256), 0, stream, pos, COS, SIN);
                hipLaunchKernelGGL(k_rmsnorm_x, dim3(M / 4), dim3(256), 0, stream, x, g_mix, XN); break;
        case 1: run_ngemm<1>(stream, XN, DM, DM, 1024, DIN, nullptr, FStore{w_in, QKVL, 1024});
                run_ngemm<2>(stream, XN, DM, DM, 32, DIN, nullptr, FKpe{w_in, KPE, COS, SIN});
                run_ngemm<1>(stream, XN, DM, DM, 1024, DIN, nullptr, FGelu{w_in + O3, U, 1024});
                run_ngemm<1>(stream, XN, DM, DM, 1024, DIN, nullptr, FGelu{w_in + O3 + 1024, GV, 1024});
                run_ngemm<1>(stream, XN, DM, DM, 4096, DIN, nullptr, FGate{w_in + O4, G, b_gate}); break;
        case 2: hipLaunchKernelGGL((k_rowscale<bf16>), dim3(M / 4), dim3(256), 0, stream, (const bf16*)QKVL, 1024, 512, RQ);
                hipLaunchKernelGGL((k_rowscale<bf16>), dim3(M / 4), dim3(256), 0, stream, (const bf16*)QKVL + 512, 1024, 512, RKV);
                hipLaunchKernelGGL((k_rowscale<bf16>), dim3(M / 4), dim3(256), 0, stream, (const bf16*)GV, 1024, 1024, RV);
                run_ngemm<1>(stream, QKVL, 1024, 512, 2048, 3072, g_q, FQnope{w_uq, Q, RQ});
                run_ngemm<2>(stream, QKVL, 1024, 512, 512, 3072, g_q, FQpe{w_uq, Q, RQ, COS, SIN});
                run_ngemm<1>(stream, QKVL + 512, 1024, 512, 4096, 4096, g_kv, FKV{w_ukv, KN, V, RKV});
                hipLaunchKernelGGL(k_sgu_naive, dim3(M * SGW / 256), dim3(256), 0, stream, (const bf16*)U, (const bf16*)GV, (const float*)RV, g_sgu, w_sgu, b_sgu, SG); break;
        case 3: hipLaunchKernelGGL(k_attn_naive, dim3(BATCH * NH * SEQ), dim3(128), 0, stream, (const bf16*)Q, (const bf16*)KN, (const bf16*)KPE, (const bf16*)V, AO);
                run_ngemm<1>(stream, SG, 1024, 1024, 2048, 2048, nullptr, FYs{w_os, YS, G}); break;
        case 4: run_ngemm<1>(stream, AO, 2048, 2048, 2048, 2048, nullptr, FMg{w_oa, MG, G, YS}); break;
        case 5: run_ngemm<1>(stream, MG, 2048, 2048, 2048, 2048, nullptr, FH1{w_out, x, H1, H1B}); break;
        case 6: hipLaunchKernelGGL((k_rowscale<float>), dim3(M / 4), dim3(256), 0, stream, (const float*)H1, 2048, 2048, RF);
                run_ngemm<2>(stream, H1B, 2048, 2048, DFF, DFF, g_ffn, FAct{w_g, w_u, ACT, RF}); break;
        case 7: run_ngemm<1>(stream, ACT, DFF, DFF, 2048, 2048, nullptr, FH2{w_d, H1}); break;
        default: hipLaunchKernelGGL(k_final_norm, dim3(M / 4), dim3(256), 0, stream, (const float*)H1, g_fin, out); break;
        }
        ++p;
    }
}
```

```cpp
#include <hip/hip_runtime.h>
#include <cstdio>
#include <cstdint>

typedef unsigned short bf16;
constexpr int BATCH = 4, SEQ = 2048, DM = 2048, M = BATCH * SEQ;
constexpr int NH = 16, DNOPE = 128, DROPE = 64, DV = 128, DQK = 192, QLR = 512, KVLR = 512;
constexpr int SGW = 1024, SGG = 8, SGD = 128, CHUNK = 128;
constexpr int DFF = 5632, DIN = 7232;
constexpr int O1 = 512, O2 = 1024, O3 = 1088, O4 = 3136;
constexpr float EPS = 1e-6f;
constexpr float QSCALE = 0.07216878364870322f * 1.4426950408889634f;
constexpr int NIN_T = 7424;

constexpr size_t MiB = 1u << 20;
constexpr size_t WS_CTL = 0, CTL_ZERO_BYTES = 64 * 1024;
constexpr size_t WS_COS = 1 * MiB, WS_SIN = 2 * MiB;
constexpr size_t WS_QSS = 3 * MiB, WS_KVSS = WS_QSS + 256 * 1024, WS_VSS = WS_KVSS + 256 * 1024;
constexpr size_t WS_H1SS = 4 * MiB, WS_H2SS = 5 * MiB;
constexpr size_t WS_RQ = 6 * MiB, WS_RKV = WS_RQ + 32768, WS_RV = WS_RKV + 32768, WS_RF = WS_RV + 32768, WS_RO = WS_RF + 32768;
constexpr size_t WS_WIN = 8 * MiB, WS_WQKV = 37 * MiB, WS_WOSGU = 44 * MiB, WS_WOATT = 48 * MiB, WS_WOUT = 56 * MiB;
constexpr size_t WS_XN = 64 * MiB, WS_AO = 64 * MiB;
constexpr size_t WS_U = 96 * MiB, WS_GV = 112 * MiB, WS_YS = 96 * MiB;
constexpr size_t WS_QKVL = 128 * MiB, WS_KPE = 144 * MiB, WS_SG = 145 * MiB, WS_Q = 161 * MiB, WS_KN = 209 * MiB, WS_V = 241 * MiB;
constexpr size_t WS_MG = 128 * MiB;
constexpr size_t WS_H1 = 161 * MiB, WS_H1B = 225 * MiB, WS_WDOWN = 257 * MiB;
constexpr size_t WS_ACT = 8 * MiB;
constexpr size_t WS_END = 279 * MiB;

__device__ __forceinline__ float bf2f(bf16 v) { return __uint_as_float((unsigned)v << 16); }
__device__ __forceinline__ bf16 f2bf(float f) { unsigned u = __float_as_uint(f); return (bf16)((u + 0x7fffu + ((u >> 16) & 1u)) >> 16); }
__device__ __forceinline__ float rbf(float f) { return bf2f(f2bf(f)); }
__device__ __forceinline__ float sigmoidf_(float x) { return __builtin_amdgcn_rcpf(1.f + __builtin_amdgcn_exp2f(-x * 1.4426950408889634f)); }
__device__ __forceinline__ float gelu_tanh(float x) { const float y = 0.7978845608028654f * (x + 0.044715f * x * x * x); return x * sigmoidf_(2.f * y); }
__device__ __forceinline__ float wave_sum(float v) {
#pragma unroll
    for (int o = 1; o < 64; o <<= 1) v += __shfl_xor(v, o);
    return v;
}
__global__ void __launch_bounds__(256) k_rope_tab(const int* __restrict__ pos, float* __restrict__ COS, float* __restrict__ SIN) {
    const int idx = blockIdx.x * 256 + threadIdx.x; if (idx >= M * 32) return;
    const int m = idx >> 5, i = idx & 31;
    const float inv = powf(10000.0f, -(float)(2 * i) / 64.0f);
    const float ang = (float)pos[m] * inv;
    COS[idx] = cosf(ang); SIN[idx] = sinf(ang);
}
__global__ void __launch_bounds__(256) k_rmsnorm_x(const float* __restrict__ x, const float* __restrict__ g, bf16* __restrict__ XN) {
    const int lane = threadIdx.x & 63, row = blockIdx.x * 4 + (threadIdx.x >> 6);
    const float* xr = x + (size_t)row * DM; float s = 0.f;
    for (int c = lane; c < DM; c += 64) { const float v = xr[c]; s += v * v; }
    const float r = 1.0f / sqrtf(wave_sum(s) * (1.0f / DM) + EPS);
    for (int c = lane; c < DM; c += 64) XN[(size_t)row * DM + c] = f2bf(xr[c] * r * g[c]);
}
template <class T> __global__ void __launch_bounds__(256) k_rowscale(const T* __restrict__ X, int ld, int K, float* __restrict__ r) {
    const int lane = threadIdx.x & 63, row = blockIdx.x * 4 + (threadIdx.x >> 6);
    float s = 0.f;
    for (int c = lane; c < K; c += 64) { float v; if constexpr (sizeof(T) == 2) v = bf2f(X[(size_t)row * ld + c]); else v = X[(size_t)row * ld + c]; s += v * v; }
    s = wave_sum(s);
    if (lane == 0) r[row] = 1.0f / sqrtf(s / (float)K + EPS);
}
template <int NC, class F>
__global__ void __launch_bounds__(256) ngemm(const bf16* __restrict__ A, int lda, int K, int N, int ldw, const float* __restrict__ kscale, F f) {
    const int n = blockIdx.x * 256 + threadIdx.x; const int m0 = blockIdx.y * 16;
    if (n >= N) return;
    const float* wp[NC];
#pragma unroll
    for (int j = 0; j < NC; ++j) wp[j] = f.col(n, j);
    float acc[NC][16];
#pragma unroll
    for (int j = 0; j < NC; ++j)
#pragma unroll
        for (int r = 0; r < 16; ++r) acc[j][r] = 0.f;
    for (int k = 0; k < K; k += 8) {
        float w[NC][8];
#pragma unroll
        for (int j = 0; j < NC; ++j)
#pragma unroll
            for (int e = 0; e < 8; ++e) w[j][e] = rbf(wp[j][(size_t)(k + e) * ldw] * (kscale ? kscale[k + e] : 1.f));
#pragma unroll
        for (int r = 0; r < 16; ++r) {
            const uint4 a = *(const uint4*)(A + (size_t)(m0 + r) * lda + k);
            const float av[8] = {__uint_as_float(a.x << 16), __uint_as_float(a.x & 0xffff0000u), __uint_as_float(a.y << 16), __uint_as_float(a.y & 0xffff0000u),
                                 __uint_as_float(a.z << 16), __uint_as_float(a.z & 0xffff0000u), __uint_as_float(a.w << 16), __uint_as_float(a.w & 0xffff0000u)};
#pragma unroll
            for (int j = 0; j < NC; ++j)
#pragma unroll
                for (int e = 0; e < 8; ++e) acc[j][r] += av[e] * w[j][e];
        }
    }
#pragma unroll
    for (int r = 0; r < 16; ++r) { float v[NC];
#pragma unroll
        for (int j = 0; j < NC; ++j) v[j] = acc[j][r];
        f.store(m0 + r, n, v); }
}
struct FStore { const float* W; bf16* O; int ldo; int pad;
    __device__ const float* col(int n, int) const { return W + n; }
    __device__ void store(int m, int n, const float (&v)[1]) const { O[(size_t)m * ldo + n] = f2bf(v[0]); } };
struct FGelu { const float* W; bf16* O; int ldo; int pad;
    __device__ const float* col(int n, int) const { return W + n; }
    __device__ void store(int m, int n, const float (&v)[1]) const { O[(size_t)m * ldo + n] = f2bf(gelu_tanh(v[0])); } };
struct FGate { const float* W; bf16* O; const float* b;
    __device__ const float* col(int n, int) const { return W + n; }
    __device__ void store(int m, int n, const float (&v)[1]) const { O[(size_t)m * 4096 + n] = f2bf(sigmoidf_(v[0] + b[n])); } };
struct FKpe { const float* W; bf16* O; const float* COS; const float* SIN;
    __device__ const float* col(int n, int j) const { return W + O2 + n + 32 * j; }
    __device__ void store(int m, int n, const float (&v)[2]) const { const float c = COS[m * 32 + n], s = SIN[m * 32 + n];
        O[(size_t)m * 64 + n] = f2bf(v[0] * c - v[1] * s); O[(size_t)m * 64 + 32 + n] = f2bf(v[1] * c + v[0] * s); } };
struct FQnope { const float* W; bf16* Q; const float* rq;
    __device__ const float* col(int n, int) const { return W + (n >> 7) * DQK + (n & 127); }
    __device__ void store(int m, int n, const float (&v)[1]) const { Q[(size_t)m * 3072 + (n >> 7) * DQK + (n & 127)] = f2bf(v[0] * rq[m] * QSCALE); } };
struct FQpe { const float* W; bf16* Q; const float* rq; const float* COS; const float* SIN;
    __device__ const float* col(int n, int j) const { return W + (n >> 5) * DQK + 128 + (n & 31) + 32 * j; }
    __device__ void store(int m, int n, const float (&v)[2]) const { const int h = n >> 5, i = n & 31; const float c = COS[m * 32 + i], s = SIN[m * 32 + i], sc = rq[m] * QSCALE;
        const float a = v[0] * sc, b = v[1] * sc; bf16* q = Q + (size_t)m * 3072 + h * DQK + 128;
        q[i] = f2bf(a * c - b * s); q[32 + i] = f2bf(b * c + a * s); } };
struct FKV { const float* W; bf16* KN; bf16* V; const float* rkv;
    __device__ const float* col(int n, int) const { return W + n; }
    __device__ void store(int m, int n, const float (&v)[1]) const { const int h = n >> 8, c = n & 255; const float o = v[0] * rkv[m];
        if (c < 128) KN[(size_t)m * 2048 + h * 128 + c] = f2bf(o); else V[(size_t)m * 2048 + h * 128 + (c - 128)] = f2bf(o); } };
struct FYs { const float* W; bf16* YS; const bf16* G;
    __device__ const float* col(int n, int) const { return W + n; }
    __device__ void store(int m, int n, const float (&v)[1]) const { YS[(size_t)m * 2048 + n] = f2bf(bf2f(G[(size_t)m * 4096 + 2048 + n]) * v[0]); } };
struct FMg { const float* W; bf16* MG; const bf16* G; const bf16* YS;
    __device__ const float* col(int n, int) const { return W + n; }
    __device__ void store(int m, int n, const float (&v)[1]) const { MG[(size_t)m * 2048 + n] = f2bf(bf2f(G[(size_t)m * 4096 + n]) * v[0] + bf2f(YS[(size_t)m * 2048 + n])); } };
struct FH1 { const float* W; const float* x; float* H1; bf16* H1B;
    __device__ const float* col(int n, int) const { return W + n; }
    __device__ void store(int m, int n, const float (&v)[1]) const { const float h = x[(size_t)m * 2048 + n] + v[0]; H1[(size_t)m * 2048 + n] = h; H1B[(size_t)m * 2048 + n] = f2bf(h); } };
struct FAct { const float* Wg; const float* Wu; bf16* ACT; const float* rf;
    __device__ const float* col(int n, int j) const { return (j ? Wu : Wg) + n; }
    __device__ void store(int m, int n, const float (&v)[2]) const { const float r = rf[m], g = v[0] * r, u = v[1] * r; ACT[(size_t)m * DFF + n] = f2bf(g * sigmoidf_(g) * u); } };
struct FH2 { const float* W; float* H;
    __device__ const float* col(int n, int) const { return W + n; }
    __device__ void store(int m, int n, const float (&v)[1]) const { H[(size_t)m * 2048 + n] += v[0]; } };

__global__ void __launch_bounds__(256) k_sgu_naive(const bf16* __restrict__ U, const bf16* __restrict__ GV, const float* __restrict__ rv, const float* __restrict__ gn,
                                                    const float* __restrict__ ws, const float* __restrict__ bs, bf16* __restrict__ SG) {
    const int idx = blockIdx.x * 256 + threadIdx.x; const int m = idx >> 10, c = idx & 1023, g = c >> 7, t = m & 127, mb = m - t;
    float s = 0.f;
    for (int j = 0; j <= t; ++j) s += rbf(ws[(g * CHUNK + t) * CHUNK + j]) * rbf(bf2f(GV[(size_t)(mb + j) * SGW + c]) * rv[mb + j] * gn[c]);
    SG[(size_t)m * SGW + c] = f2bf(bf2f(U[(size_t)m * SGW + c]) * (s + bs[g * CHUNK + t]));
}
__global__ void __launch_bounds__(128) k_attn_naive(const bf16* __restrict__ Q, const bf16* __restrict__ KN, const bf16* __restrict__ KPE, const bf16* __restrict__ V, bf16* __restrict__ AO) {
    __shared__ float qs[DQK]; __shared__ float sc[SEQ]; __shared__ float red[128];
    const int tid = threadIdx.x; const int q = blockIdx.x % SEQ, bh = blockIdx.x / SEQ, h = bh % NH, b = bh / NH;
    const size_t mq = (size_t)b * SEQ + q;
    for (int i = tid; i < DQK; i += 128) qs[i] = bf2f(Q[mq * 3072 + h * DQK + i]);
    __syncthreads();
    float mx = -1e30f;
    for (int j = tid; j <= q; j += 128) { const size_t mk = (size_t)b * SEQ + j; float s = 0.f;
        const bf16* kr = KN + mk * 2048 + h * 128; for (int d = 0; d < 128; ++d) s += qs[d] * bf2f(kr[d]);
        const bf16* kp = KPE + mk * 64; for (int d = 0; d < 64; ++d) s += qs[128 + d] * bf2f(kp[d]);
        sc[j] = s; mx = fmaxf(mx, s); }
    red[tid] = mx; __syncthreads();
    for (int o = 64; o > 0; o >>= 1) { if (tid < o) red[tid] = fmaxf(red[tid], red[tid + o]); __syncthreads(); }
    mx = red[0]; __syncthreads();
    float l = 0.f;
    for (int j = tid; j <= q; j += 128) { const float p = exp2f(sc[j] - mx); l += p; sc[j] = rbf(p); }
    red[tid] = l; __syncthreads();
    for (int o = 64; o > 0; o >>= 1) { if (tid < o) red[tid] += red[tid + o]; __syncthreads(); }
    l = red[0];
    float o = 0.f;
    for (int j = 0; j <= q; ++j) o += sc[j] * bf2f(V[((size_t)b * SEQ + j) * 2048 + h * 128 + tid]);
    AO[mq * 2048 + h * 128 + tid] = f2bf(o / l);
}
__global__ void __launch_bounds__(256) k_final_norm(const float* __restrict__ H, const float* __restrict__ g, float* __restrict__ out) {
    const int lane = threadIdx.x & 63, row = blockIdx.x * 4 + (threadIdx.x >> 6);
    const float* hr = H + (size_t)row * DM; float s = 0.f;
    for (int c = lane; c < DM; c += 64) { const float v = hr[c]; s += v * v; }
    const float r = 1.0f / sqrtf(wave_sum(s) * (1.0f / DM) + EPS);
    for (int c = lane; c < DM; c += 64) out[(size_t)row * DM + c] = hr[c] * r * g[c];
}


namespace pg8 {
#define PG8_LAS __attribute__((address_space(3)))
typedef unsigned short bf16_t;
typedef short bf16x8 __attribute__((ext_vector_type(8)));
typedef float f32x4 __attribute__((ext_vector_type(4)));
typedef float f32x2 __attribute__((ext_vector_type(2)));
typedef unsigned u32x4 __attribute__((ext_vector_type(4)));
typedef unsigned u32x2 __attribute__((ext_vector_type(2)));
constexpr int BM = 256, BK = 64, HALF = 128, HTB = HALF * BK * 2  , STAGE_BYTES = 8 * HTB, NXCD = 8, WGM = 8;

__host__ __device__ __forceinline__ int lds_byte(int r, int c) { const int st = (r >> 4) * 2 + (c >> 5), rr = r & 15, cc = c & 31, ob = rr * 64 + cc * 2; return st * 1024 + (ob ^ (((ob >> 9) & 1) << 5)); }
__host__ __device__ __forceinline__ void stage_rc(int b, int& R, int& C) { const int st = b / 1024, sb = b % 1024, swz = sb ^ (((sb >> 9) & 1) << 5); R = (st >> 1) * 16 + swz / 64; C = (st & 1) * 32 + (swz % 64) / 2; }
__host__ __device__ __forceinline__ int perm32(int rho) { const int n = rho >> 4, i = rho & 15; return 8 * (i >> 2) + 4 * n + (i & 3); }

struct Unit { int pm, pn, aoff; };
struct Gemm { const bf16_t* A; const bf16_t* Bt; int lda, ldb, K; };

struct StaticOrder {
    int nM, nN, nwg, G, c, split, split_aoff;
    __host__ __device__ void init(int M_, int N_, int G_, int c_, int split_ = 1 << 30, int split_aoff_ = 0) { nM = M_ / BM; nN = N_ / BM; nwg = nM * nN; G = G_; c = c_; split = split_; split_aoff = split_aoff_; }
    __host__ __device__ bool next(int i, Unit& u) const {
        const long L = (long)i * G + c; if (L >= nwg) return false;
        int wgid = (int)L; { const int q = nwg / NXCD, r = nwg % NXCD, xcd = wgid % NXCD, off = wgid / NXCD; wgid = (xcd < r ? xcd * (q + 1) : r * (q + 1) + (xcd - r) * q) + off; }
        const int nig = WGM * nN, gid = wgid / nig, fm = gid * WGM, gsz = (nM - fm) < WGM ? (nM - fm) : WGM;
        u.pm = fm + ((wgid % nig) % gsz); u.pn = (wgid % nig) / gsz; u.aoff = (u.pn >= split) ? split_aoff : 0; return true;
    }
    __device__ __forceinline__ void a_ready(const Unit&) const {}
    __device__ __forceinline__ void done(const Unit&) const {}
};
__device__ __forceinline__ unsigned cvt_pk_bf16(float lo, float hi) { unsigned r; asm volatile("v_cvt_pk_bf16_f32 %0, %1, %2" : "=v"(r) : "v"(lo), "v"(hi)); return r; }

template <class Epi, class Sched, bool ALIGN_EPI = false, bool SP2 = false>
__device__ __forceinline__ void gemm_phase(PG8_LAS unsigned char* lds, const Gemm g, const Sched& S, const Epi& E) {
    const int tid = threadIdx.x, wid = __builtin_amdgcn_readfirstlane(tid >> 6), lane = tid & 63, wr = wid >> 2, wc = wid & 3, fr = lane & 15, fq = lane >> 4;
    const int K = g.K, nt = K / BK;
    unsigned voffA[2], voffB[2];
#pragma unroll
    for (int i = 0; i < 2; ++i) { int R, C; stage_rc(tid * 16 + i * 8192, R, C); const int Rb = Epi::PERM ? ((R & ~31) + perm32(R & 31)) : R;
        voffA[i] = (unsigned)(R * g.lda + C) * 2u; voffB[i] = (unsigned)(Rb * g.ldb + C) * 2u; }
    const size_t kstep = (size_t)(BK * 2);
    const size_t hsA = (size_t)HALF * g.lda * 2, hsB = (size_t)HALF * g.ldb * 2;
    const size_t tsA = 2 * hsA, tsB = 2 * hsB;
    const unsigned ldsw = (unsigned)wid * 1024u;
    const int aoff = lds_byte(wr * 64 + fr, fq * 8), boff = lds_byte(wc * 32 + fr, fq * 8);
#define PG8_SA(b, h) (((b) * 2 + (h)) * HTB)
#define PG8_SB(b, h) ((4 + (b) * 2 + (h)) * HTB)
#define PG8_STAGE(bufoff, gbase, voff) do { _Pragma("unroll") for (int _i = 0; _i < 2; ++_i) \
        __builtin_amdgcn_global_load_lds((const unsigned*)((const char*)(gbase) + (voff)[_i]), (PG8_LAS unsigned*)(lds + (bufoff) + ldsw + _i * 8192), 16, 0, 0); } while (0)
#define PG8_LDA(dst, b, h) do { _Pragma("unroll") for (int m = 0; m < 4; ++m) _Pragma("unroll") for (int k = 0; k < 2; ++k) dst[m][k] = *(const PG8_LAS bf16x8*)(lds + PG8_SA(b, h) + aoff + m * 2048 + k * 1024); } while (0)
#define PG8_LDB(dst, b, h) do { _Pragma("unroll") for (int n = 0; n < 2; ++n) _Pragma("unroll") for (int k = 0; k < 2; ++k) dst[n][k] = *(const PG8_LAS bf16x8*)(lds + PG8_SB(b, h) + boff + n * 2048 + k * 1024); } while (0)
#define PG8_MMA(ai, bj, At, Bt) do { __builtin_amdgcn_s_setprio(1); _Pragma("unroll") for (int m = 0; m < 4; ++m) _Pragma("unroll") for (int n = 0; n < 2; ++n) _Pragma("unroll") for (int k = 0; k < 2; ++k) \
        acc[ai][bj][m][n] = __builtin_amdgcn_mfma_f32_16x16x32_bf16(Bt[n][k], At[m][k], acc[ai][bj][m][n], 0, 0, 0); __builtin_amdgcn_s_setprio(0); } while (0)
#define PG8_WAIT_V(n) asm volatile("s_waitcnt vmcnt(" #n ")" ::: "memory")
#define PG8_WAIT_L(n) asm volatile("s_waitcnt lgkmcnt(" #n ")" ::: "memory")
#define PG8_BAR __builtin_amdgcn_s_barrier()
#define PG8_SCHED __builtin_amdgcn_sched_barrier(0)
    Unit cur, nxt; int ui = 0;
    if (!S.next(0, cur)) return;
    f32x4 acc[2][2][4][2];
#pragma unroll
    for (int a = 0; a < 2; ++a)
#pragma unroll
        for (int b = 0; b < 2; ++b)
#pragma unroll
            for (int m = 0; m < 4; ++m)
#pragma unroll
                for (int n = 0; n < 2; ++n) acc[a][b][m][n] = (f32x4){0.f, 0.f, 0.f, 0.f};
    bf16x8 At[4][2], B0[2][2], B1[2][2];
    const char* cA = (const char*)g.A + (size_t)cur.pm * tsA + (size_t)cur.aoff * 2; const char* cB = (const char*)g.Bt + (size_t)cur.pn * tsB;
    S.a_ready(cur);
    if constexpr (SP2) {
        PG8_STAGE(PG8_SB(0, 0), cB, voffB); PG8_STAGE(PG8_SB(0, 1), cB + hsB, voffB); PG8_STAGE(PG8_SA(0, 0), cA, voffA); PG8_STAGE(PG8_SA(0, 1), cA + hsA, voffA);
        if (wr == 1) PG8_BAR;
        PG8_WAIT_V(2); PG8_BAR;
        PG8_STAGE(PG8_SB(1, 0), cB + kstep, voffB); PG8_STAGE(PG8_SA(1, 0), cA + kstep, voffA); PG8_STAGE(PG8_SB(1, 1), cB + hsB + kstep, voffB);
        PG8_WAIT_V(6); PG8_BAR;
    } else {
        PG8_STAGE(PG8_SB(0, 0), cB, voffB); PG8_STAGE(PG8_SA(0, 0), cA, voffA); PG8_STAGE(PG8_SB(0, 1), cB + hsB, voffB); PG8_STAGE(PG8_SA(0, 1), cA + hsA, voffA);
        if (wr == 1) PG8_BAR;
        PG8_WAIT_V(4); PG8_BAR;
        PG8_STAGE(PG8_SB(1, 0), cB + kstep, voffB); PG8_STAGE(PG8_SA(1, 0), cA + kstep, voffA); PG8_STAGE(PG8_SB(1, 1), cB + hsB + kstep, voffB);
        PG8_WAIT_V(6); PG8_BAR;
    }
    for (;;) {
        const bool has_next = S.next(ui + 1, nxt);
        const char* nA = has_next ? (const char*)g.A + (size_t)nxt.pm * tsA + (size_t)nxt.aoff * 2 : cA; const char* nB = has_next ? (const char*)g.Bt + (size_t)nxt.pn * tsB : cB;
        for (int t = 0; t < nt; t += 2) {
            const bool last = (t == nt - 2);
            const char* a1 = cA + (size_t)(t + 1) * kstep;
            const char* a2 = last ? nA : cA + (size_t)(t + 2) * kstep; const char* b2 = last ? nB : cB + (size_t)(t + 2) * kstep;
            const char* a3 = a2 + kstep; const char* b3 = b2 + kstep;
            if (last && has_next) S.a_ready(nxt);
            if constexpr (SP2) {
            PG8_LDB(B0, 0, 0); PG8_LDB(B1, 0, 1); PG8_SCHED; PG8_LDA(At, 0, 0); PG8_STAGE(PG8_SA(1, 1), a1 + hsA, voffA);
            PG8_WAIT_V(8); PG8_WAIT_L(0); PG8_BAR; PG8_MMA(0, 0, At, B0); PG8_MMA(0, 1, At, B1); PG8_BAR; PG8_SCHED;
            PG8_LDA(At, 0, 1); PG8_STAGE(PG8_SB(0, 0), b2, voffB); PG8_STAGE(PG8_SB(0, 1), b2 + hsB, voffB); PG8_STAGE(PG8_SA(0, 0), a2, voffA);
            PG8_WAIT_V(8); PG8_WAIT_L(0); PG8_BAR; PG8_MMA(1, 0, At, B0); PG8_MMA(1, 1, At, B1); PG8_BAR; PG8_SCHED;
            PG8_LDB(B0, 1, 0); PG8_LDB(B1, 1, 1); PG8_SCHED; PG8_LDA(At, 1, 0); PG8_STAGE(PG8_SA(0, 1), a2 + hsA, voffA);
            PG8_WAIT_V(8); PG8_WAIT_L(0); PG8_BAR; PG8_MMA(0, 0, At, B0); PG8_MMA(0, 1, At, B1); PG8_BAR; PG8_SCHED;
            PG8_LDA(At, 1, 1); PG8_STAGE(PG8_SB(1, 0), b3, voffB); PG8_STAGE(PG8_SB(1, 1), b3 + hsB, voffB); PG8_STAGE(PG8_SA(1, 0), a3, voffA);
            PG8_WAIT_V(8); PG8_WAIT_L(0); PG8_BAR; PG8_MMA(1, 0, At, B0); PG8_MMA(1, 1, At, B1); PG8_BAR; PG8_SCHED;
            } else {
            PG8_LDB(B0, 0, 0); PG8_SCHED; PG8_LDA(At, 0, 0); PG8_STAGE(PG8_SA(1, 1), a1 + hsA, voffA);
            PG8_WAIT_L(8); PG8_BAR; PG8_WAIT_L(0); PG8_MMA(0, 0, At, B0); PG8_BAR; PG8_SCHED;
            PG8_LDB(B1, 0, 1); PG8_STAGE(PG8_SB(0, 0), b2, voffB);
            PG8_BAR; PG8_WAIT_L(0); PG8_MMA(0, 1, At, B1); PG8_BAR;
            PG8_LDA(At, 0, 1); PG8_STAGE(PG8_SA(0, 0), a2, voffA);
            PG8_BAR; PG8_WAIT_L(0); PG8_MMA(1, 0, At, B0); PG8_BAR; PG8_SCHED;
            PG8_STAGE(PG8_SB(0, 1), b2 + hsB, voffB);
            PG8_WAIT_V(6); PG8_BAR; PG8_MMA(1, 1, At, B1); PG8_BAR;
            PG8_LDB(B0, 1, 0); PG8_SCHED; PG8_LDA(At, 1, 0); PG8_STAGE(PG8_SA(0, 1), a2 + hsA, voffA);
            PG8_WAIT_L(8); PG8_BAR; PG8_WAIT_L(0); PG8_MMA(0, 0, At, B0); PG8_BAR; PG8_SCHED;
            PG8_LDB(B1, 1, 1); PG8_STAGE(PG8_SB(1, 0), b3, voffB);
            PG8_BAR; PG8_WAIT_L(0); PG8_MMA(0, 1, At, B1); PG8_BAR;
            PG8_LDA(At, 1, 1); PG8_STAGE(PG8_SA(1, 0), a3, voffA);
            PG8_BAR; PG8_WAIT_L(0); PG8_MMA(1, 0, At, B0); PG8_BAR; PG8_SCHED;
            PG8_STAGE(PG8_SB(1, 1), b3 + hsB, voffB);
            PG8_WAIT_V(6); PG8_BAR; PG8_MMA(1, 1, At, B1); PG8_BAR;
            }
        }
        if constexpr (ALIGN_EPI) { if (wr == 0) PG8_BAR; }
        if constexpr (!Epi::AFTER_DRAIN) { E(acc, cur, wr, wc, fr, fq); S.done(cur); }
        if (!has_next) break;
#pragma unroll
        for (int a = 0; a < 2; ++a)
#pragma unroll
            for (int b = 0; b < 2; ++b)
#pragma unroll
                for (int m = 0; m < 4; ++m)
#pragma unroll
                    for (int n = 0; n < 2; ++n) acc[a][b][m][n] = (f32x4){0.f, 0.f, 0.f, 0.f};
        cur = nxt; cA = nA; cB = nB; ++ui;
        if constexpr (ALIGN_EPI) { if (wr == 1) PG8_BAR; }
    }
    PG8_WAIT_V(0);
    if constexpr (!ALIGN_EPI) { if (wr == 0) PG8_BAR; }
    PG8_BAR;
    if constexpr (Epi::AFTER_DRAIN) { E.fused(acc, cur, wr, wc, fr, fq, lds, wid, lane); S.done(cur); }
#undef PG8_SA
#undef PG8_SB
#undef PG8_STAGE
#undef PG8_LDA
#undef PG8_LDB
#undef PG8_MMA
#undef PG8_WAIT_V
#undef PG8_WAIT_L
#undef PG8_BAR
#undef PG8_SCHED
}

}

namespace epi {
using pg8::f32x4; using pg8::f32x2; using pg8::u32x4; using pg8::u32x2; using pg8::Unit;
typedef __bf16 bf16x2_t __attribute__((ext_vector_type(2)));
__device__ __forceinline__ unsigned cvtpk(float lo, float hi) { f32x2 v = {lo, hi}; bf16x2_t b = __builtin_convertvector(v, bf16x2_t); return __builtin_bit_cast(unsigned, b); }
__device__ __forceinline__ float fqsum(float s) { s += __shfl_xor(s, 16); s += __shfl_xor(s, 32); return s; }
__device__ __forceinline__ float sq4(f32x4 v) { return (v[0] * v[0] + v[1] * v[1]) + (v[2] * v[2] + v[3] * v[3]); }
__device__ __forceinline__ u32x4 pack8(f32x4 a, f32x4 b) { u32x4 w; w.x = cvtpk(a[0], a[1]); w.y = cvtpk(a[2], a[3]); w.z = cvtpk(b[0], b[1]); w.w = cvtpk(b[2], b[3]); return w; }
__device__ __forceinline__ u32x2 pack4(f32x4 a) { u32x2 w; w.x = cvtpk(a[0], a[1]); w.y = cvtpk(a[2], a[3]); return w; }
__device__ __forceinline__ void unpack8(u32x4 w, f32x4& a, f32x4& b) {
    a[0] = __uint_as_float(w.x << 16); a[1] = __uint_as_float(w.x & 0xffff0000u); a[2] = __uint_as_float(w.y << 16); a[3] = __uint_as_float(w.y & 0xffff0000u);
    b[0] = __uint_as_float(w.z << 16); b[1] = __uint_as_float(w.z & 0xffff0000u); b[2] = __uint_as_float(w.w << 16); b[3] = __uint_as_float(w.w & 0xffff0000u); }
__device__ __forceinline__ f32x4 gelu4(f32x4 v) { f32x4 o; o[0] = gelu_tanh(v[0]); o[1] = gelu_tanh(v[1]); o[2] = gelu_tanh(v[2]); o[3] = gelu_tanh(v[3]); return o; }
__device__ __forceinline__ f32x4 sigm4(f32x4 v) { f32x4 o; o[0] = sigmoidf_(v[0]); o[1] = sigmoidf_(v[1]); o[2] = sigmoidf_(v[2]); o[3] = sigmoidf_(v[3]); return o; }
template <int NSLOT> __device__ __forceinline__ void row_scales(const float* SS, int row0, int fq, float inv_n, float (&rs)[2][4]) {
#pragma unroll
    for (int ai = 0; ai < 2; ++ai)
#pragma unroll
        for (int m = 0; m < 4; ++m) { const float* p = SS + (size_t)(row0 + ai * 128 + m * 16) * NSLOT + fq * (NSLOT / 4); float s;
            if constexpr (NSLOT == 8) { const f32x2 v = *(const f32x2*)p; s = v[0] + v[1]; }
            else if constexpr (NSLOT == 16) { const f32x4 v = *(const f32x4*)p; s = (v[0] + v[1]) + (v[2] + v[3]); }
            else { const f32x4 v = *(const f32x4*)p, w = *(const f32x4*)(p + 4); s = ((v[0] + v[1]) + (v[2] + v[3])) + ((w[0] + w[1]) + (w[2] + w[3])); }
            s = fqsum(s); rs[ai][m] = 1.0f / sqrtf(s * inv_n + EPS); }
}
#define EPI_ROWS _Pragma("unroll") for (int ai = 0; ai < 2; ++ai) _Pragma("unroll") for (int m = 0; m < 4; ++m)
#define EPI_BJ _Pragma("unroll") for (int bj = 0; bj < 2; ++bj)

struct EpiP1 {
    static constexpr bool PERM = true, AFTER_DRAIN = false;
    bf16* QKVL; bf16* U; bf16* GV; bf16* G; bf16* KPE; float* QSS; float* KVSS; float* VSS; const float* b_gate; const float* COS; const float* SIN;
    __device__ __forceinline__ void operator()(const f32x4 (&acc)[2][2][4][2], const Unit& u, int wr, int wc, int fr, int fq) const {
        const int row0 = u.pm * 256 + wr * 64 + fr, pn = u.pn, cw = wc * 32 + 8 * fq;
        if (pn < 4) {
            float* SS = (pn < 2) ? QSS : KVSS; const int slot = (pn & 1) * 4 + wc;
            EPI_ROWS { const int row = row0 + ai * 128 + m * 16; float ss = 0.f;
                EPI_BJ { const f32x4 v0 = acc[ai][bj][m][0], v1 = acc[ai][bj][m][1]; ss += sq4(v0) + sq4(v1);
                    *(u32x4*)(QKVL + (size_t)row * 1024 + pn * 256 + bj * 128 + cw) = pack8(v0, v1); }
                ss = fqsum(ss); if (fq == 0) SS[(size_t)row * 8 + slot] = ss; }
        } else if (pn < 12) {
            const bool isv = pn >= 8; bf16* O = isv ? GV : U; const int ct = (pn - (isv ? 8 : 4)) * 256;
            EPI_ROWS { const int row = row0 + ai * 128 + m * 16; float ss = 0.f;
                EPI_BJ { const f32x4 v0 = gelu4(acc[ai][bj][m][0]), v1 = gelu4(acc[ai][bj][m][1]); ss += sq4(v0) + sq4(v1);
                    *(u32x4*)(O + (size_t)row * 1024 + ct + bj * 128 + cw) = pack8(v0, v1); }
                if (isv) { ss = fqsum(ss); if (fq == 0) VSS[(size_t)row * 16 + (pn - 8) * 4 + wc] = ss; } }
        } else if (pn < 28) {
            const int ct = (pn - 12) * 256; f32x4 bv[2][2];
            EPI_BJ { bv[bj][0] = *(const f32x4*)(b_gate + ct + bj * 128 + cw); bv[bj][1] = *(const f32x4*)(b_gate + ct + bj * 128 + cw + 4); }
            EPI_ROWS { const int row = row0 + ai * 128 + m * 16;
                EPI_BJ { const f32x4 v0 = sigm4(acc[ai][bj][m][0] + bv[bj][0]), v1 = sigm4(acc[ai][bj][m][1] + bv[bj][1]);
                    *(u32x4*)(G + (size_t)row * 4096 + ct + bj * 128 + cw) = pack8(v0, v1); } }
        } else {
            if (wc < 2) { const int j4 = 4 * (4 * wc + fq);
                EPI_ROWS { const int row = row0 + ai * 128 + m * 16;
                    const f32x4 c = *(const f32x4*)(COS + (size_t)row * 32 + j4), s = *(const f32x4*)(SIN + (size_t)row * 32 + j4);
                    const f32x4 x1 = acc[ai][0][m][0], x2 = acc[ai][0][m][1];
                    *(u32x2*)(KPE + (size_t)row * 64 + j4) = pack4(x1 * c - x2 * s); *(u32x2*)(KPE + (size_t)row * 64 + 32 + j4) = pack4(x2 * c + x1 * s); } }
        }
    }
};
struct EpiP2 {
    static constexpr bool PERM = true, AFTER_DRAIN = false;
    bf16* Q; bf16* KN; bf16* V; const float* QSS; const float* KVSS; const float* COS; const float* SIN;
    __device__ __forceinline__ void operator()(const f32x4 (&acc)[2][2][4][2], const Unit& u, int wr, int wc, int fr, int fq) const {
        const int row0 = u.pm * 256 + wr * 64 + fr, pn = u.pn, cw = wc * 32 + 8 * fq;
        float rs[2][4]; row_scales<8>(pn < 12 ? QSS : KVSS, row0, fq, 1.0f / 512.0f, rs);
        if (pn < 8) {
            EPI_ROWS { const int row = row0 + ai * 128 + m * 16; const float sc = rs[ai][m] * QSCALE;
                EPI_BJ { *(u32x4*)(Q + (size_t)row * 3072 + (2 * pn + bj) * DQK + cw) = pack8(acc[ai][bj][m][0] * sc, acc[ai][bj][m][1] * sc); } }
        } else if (pn < 12) {
            EPI_ROWS { const int row = row0 + ai * 128 + m * 16; const float sc = rs[ai][m] * QSCALE;
                EPI_BJ { const int cc = bj * 128 + cw, h = 4 * (pn - 8) + (cc >> 6), j4 = (cc & 63) >> 1;
                    const f32x4 c = *(const f32x4*)(COS + (size_t)row * 32 + j4), s = *(const f32x4*)(SIN + (size_t)row * 32 + j4);
                    const f32x4 x1 = acc[ai][bj][m][0] * sc, x2 = acc[ai][bj][m][1] * sc; bf16* q = Q + (size_t)row * 3072 + h * DQK + 128 + j4;
                    *(u32x2*)q = pack4(x1 * c - x2 * s); *(u32x2*)(q + 32) = pack4(x2 * c + x1 * s); } }
        } else {
            const int h = pn - 12;
            EPI_ROWS { const int row = row0 + ai * 128 + m * 16; const float sc = rs[ai][m];
                *(u32x4*)(KN + (size_t)row * 2048 + h * 128 + cw) = pack8(acc[ai][0][m][0] * sc, acc[ai][0][m][1] * sc);
                *(u32x4*)(V + (size_t)row * 2048 + h * 128 + cw) = pack8(acc[ai][1][m][0] * sc, acc[ai][1][m][1] * sc); }
        }
    }
};
struct EpiYs {
    static constexpr bool PERM = true, AFTER_DRAIN = false;
    bf16* YS; const bf16* G;
    __device__ __forceinline__ void operator()(const f32x4 (&acc)[2][2][4][2], const Unit& u, int wr, int wc, int fr, int fq) const {
        const int row0 = u.pm * 256 + wr * 64 + fr, col0 = u.pn * 256 + wc * 32 + 8 * fq;
        EPI_ROWS { const int row = row0 + ai * 128 + m * 16;
            EPI_BJ { const int col = col0 + bj * 128; f32x4 g0, g1; unpack8(*(const u32x4*)(G + (size_t)row * 4096 + 2048 + col), g0, g1);
                *(u32x4*)(YS + (size_t)row * 2048 + col) = pack8(acc[ai][bj][m][0] * g0, acc[ai][bj][m][1] * g1); } }
    }
};
struct EpiMg {
    static constexpr bool PERM = true, AFTER_DRAIN = false;
    bf16* MG; const bf16* G; const bf16* YS;
    __device__ __forceinline__ void operator()(const f32x4 (&acc)[2][2][4][2], const Unit& u, int wr, int wc, int fr, int fq) const {
        const int row0 = u.pm * 256 + wr * 64 + fr, col0 = u.pn * 256 + wc * 32 + 8 * fq;
        EPI_ROWS { const int row = row0 + ai * 128 + m * 16;
            EPI_BJ { const int col = col0 + bj * 128; f32x4 g0, g1, y0, y1; unpack8(*(const u32x4*)(G + (size_t)row * 4096 + col), g0, g1); unpack8(*(const u32x4*)(YS + (size_t)row * 2048 + col), y0, y1);
                *(u32x4*)(MG + (size_t)row * 2048 + col) = pack8(acc[ai][bj][m][0] * g0 + y0, acc[ai][bj][m][1] * g1 + y1); } }
    }
};
struct EpiH1 {
    static constexpr bool PERM = true, AFTER_DRAIN = false;
    const float* x; float* H1; bf16* H1B; float* H1SS;
    __device__ __forceinline__ void operator()(const f32x4 (&acc)[2][2][4][2], const Unit& u, int wr, int wc, int fr, int fq) const {
        const int row0 = u.pm * 256 + wr * 64 + fr, col0 = u.pn * 256 + wc * 32 + 8 * fq;
        EPI_ROWS { const int row = row0 + ai * 128 + m * 16; float ss = 0.f;
            EPI_BJ { const size_t o = (size_t)row * 2048 + col0 + bj * 128;
                const f32x4 h0 = *(const f32x4*)(x + o) + acc[ai][bj][m][0], h1 = *(const f32x4*)(x + o + 4) + acc[ai][bj][m][1]; ss += sq4(h0) + sq4(h1);
                *(f32x4*)(H1 + o) = h0; *(f32x4*)(H1 + o + 4) = h1; *(u32x4*)(H1B + o) = pack8(h0, h1); }
            ss = fqsum(ss); if (fq == 0) H1SS[(size_t)row * 32 + u.pn * 4 + wc] = ss; }
    }
};
struct EpiAct {
    static constexpr bool PERM = true, AFTER_DRAIN = false;
    bf16* ACT; const float* H1SS;
    __device__ __forceinline__ void operator()(const f32x4 (&acc)[2][2][4][2], const Unit& u, int wr, int wc, int fr, int fq) const {
        const int row0 = u.pm * 256 + wr * 64 + fr, col0 = u.pn * 128 + wc * 32 + 8 * fq;
        float rs[2][4]; row_scales<32>(H1SS, row0, fq, 1.0f / 2048.0f, rs);
        EPI_ROWS { const int row = row0 + ai * 128 + m * 16; const float r = rs[ai][m]; f32x4 o[2];
#pragma unroll
            for (int n = 0; n < 2; ++n) { const f32x4 g = acc[ai][0][m][n] * r, up = acc[ai][1][m][n] * r; o[n] = g * sigm4(g) * up; }
            *(u32x4*)(ACT + (size_t)row * DFF + col0) = pack8(o[0], o[1]); }
    }
};
struct EpiH2 {
    static constexpr bool PERM = true, AFTER_DRAIN = false;
    const float* H; float* O; float* H2SS;
    __device__ __forceinline__ void operator()(const f32x4 (&acc)[2][2][4][2], const Unit& u, int wr, int wc, int fr, int fq) const {
        const int row0 = u.pm * 256 + wr * 64 + fr, col0 = u.pn * 256 + wc * 32 + 8 * fq;
        EPI_ROWS { const int row = row0 + ai * 128 + m * 16; float ss = 0.f;
            EPI_BJ { const size_t o = (size_t)row * 2048 + col0 + bj * 128;
                const f32x4 h0 = *(const f32x4*)(H + o) + acc[ai][bj][m][0], h1 = *(const f32x4*)(H + o + 4) + acc[ai][bj][m][1]; ss += sq4(h0) + sq4(h1);
                *(f32x4*)(O + o) = h0; *(f32x4*)(O + o + 4) = h1; }
            ss = fqsum(ss); if (fq == 0) H2SS[(size_t)row * 32 + u.pn * 4 + wc] = ss; }
    }
};
}

#define LAS __attribute__((address_space(3)))
#define GAS __attribute__((address_space(1)))
namespace sgu {
using pg8::f32x4; using pg8::u32x4; using pg8::u32x2; using pg8::bf16x8;
constexpr int TP = 136;
constexpr int LDS_T = 0, LDS_W = 128 * TP * 2, LDS_R = 2 * 128 * TP * 2, LDS_BYTES = LDS_R + 512;
__device__ __forceinline__ void sgu_unit(LAS unsigned char* lds, int unit, const bf16* U, const bf16* GV, const float* VSS, const float* gn, const float* ws, const float* bs, bf16* SG) {
    const int tid = threadIdx.x, lane = tid & 63, wid = __builtin_amdgcn_readfirstlane(tid >> 6), fr = lane & 15, fq = lane >> 4;
    const int g = unit & 7, m0 = (unit >> 3) * 128, c0 = g * 128;
    LAS bf16* T = (LAS bf16*)(lds + LDS_T); LAS bf16* WSL = (LAS bf16*)(lds + LDS_W); LAS float* rvs = (LAS float*)(lds + LDS_R);
    if (tid < 128) { const f32x4* p = (const f32x4*)(VSS + (size_t)(m0 + tid) * 16); float s = 0.f;
#pragma unroll
        for (int i = 0; i < 4; ++i) { const f32x4 v = p[i]; s += (v[0] + v[1]) + (v[2] + v[3]); }
        rvs[tid] = 1.0f / sqrtf(s * (1.0f / 1024.0f) + EPS); }
    __syncthreads();
#pragma unroll
    for (int i = 0; i < 4; ++i) { const int idx = tid + 512 * i, s = idx >> 4, dc = (idx & 15) * 8;
        f32x4 v0, v1; epi::unpack8(*(const u32x4*)(GV + (size_t)(m0 + s) * SGW + c0 + dc), v0, v1);
        const f32x4 g0 = *(const f32x4*)(gn + c0 + dc), g1 = *(const f32x4*)(gn + c0 + dc + 4); const float r = rvs[s];
        v0 = v0 * r * g0; v1 = v1 * r * g1;
#pragma unroll
        for (int e = 0; e < 4; ++e) { T[(dc + e) * TP + s] = f2bf(v0[e]); T[(dc + 4 + e) * TP + s] = f2bf(v1[e]); } }
#pragma unroll
    for (int i = 0; i < 8; ++i) { const int idx = tid + 512 * i, t = idx >> 5, s4 = (idx & 31) * 4;
        f32x4 w = *(const f32x4*)(ws + (size_t)(g * CHUNK + t) * CHUNK + s4);
#pragma unroll
        for (int e = 0; e < 4; ++e) w[e] = (s4 + e <= t) ? w[e] : 0.f;
        *(LAS u32x2*)(WSL + t * TP + s4) = epi::pack4(w); }
    __syncthreads();
    f32x4 acc[8];
#pragma unroll
    for (int nt = 0; nt < 8; ++nt) acc[nt] = (f32x4){0.f, 0.f, 0.f, 0.f};
#pragma unroll
    for (int ks = 0; ks < 4; ++ks) {
        if (32 * ks <= 16 * wid + 15) {
            const bf16x8 bw = *(const LAS bf16x8*)(WSL + (16 * wid + fr) * TP + 32 * ks + 8 * fq);
#pragma unroll
            for (int nt = 0; nt < 8; ++nt) { const bf16x8 at = *(const LAS bf16x8*)(T + (16 * nt + fr) * TP + 32 * ks + 8 * fq);
                acc[nt] = __builtin_amdgcn_mfma_f32_16x16x32_bf16(at, bw, acc[nt], 0, 0, 0); } }
    }
    const int t = 16 * wid + fr; const float bt = bs[g * CHUNK + t]; const size_t ro = (size_t)(m0 + t) * SGW + c0 + 4 * fq;
#pragma unroll
    for (int nt = 0; nt < 8; ++nt) { const u32x2 uw = *(const u32x2*)(U + ro + 16 * nt); f32x4 uu;
        uu[0] = __uint_as_float(uw.x << 16); uu[1] = __uint_as_float(uw.x & 0xffff0000u); uu[2] = __uint_as_float(uw.y << 16); uu[3] = __uint_as_float(uw.y & 0xffff0000u);
        *(u32x2*)(SG + ro + 16 * nt) = epi::pack4(uu * (acc[nt] + bt)); }
    __syncthreads();
}
}

namespace att {
typedef short bf16x8 __attribute__((ext_vector_type(8)));
typedef short s16x4 __attribute__((ext_vector_type(4)));
typedef float f32x16 __attribute__((ext_vector_type(16)));
typedef float f32x4 __attribute__((ext_vector_type(4)));
constexpr int KSLOT = 24576, VSLOT = 16384, SLOT = KSLOT + VSLOT, NSLOT = 2, LDS_BYTES = NSLOT * SLOT;
__device__ __forceinline__ void glds16(const void* gsrc, unsigned lds_dst) { unsigned keep;
    asm volatile("s_mov_b32 %0, m0\n\ts_mov_b32 m0, %2\n\ts_nop 0\n\tglobal_load_lds_dwordx4 %1, off\n\ts_mov_b32 m0, %0" : "=&s"(keep) : "v"(gsrc), "s"(lds_dst) : "memory"); }
__device__ __forceinline__ s16x4 vtr(const LAS char* p) { typedef short v4i16_t __attribute__((ext_vector_type(4))); return __builtin_bit_cast(s16x4, __builtin_amdgcn_ds_read_tr16_b64_v4i16((LAS v4i16_t*)p)); }
__device__ __forceinline__ bf16x8 pack8(const f32x16& p, int b) { pg8::u32x4 w; w.x = epi::cvtpk(p[b], p[b + 1]); w.y = epi::cvtpk(p[b + 2], p[b + 3]); w.z = epi::cvtpk(p[b + 4], p[b + 5]); w.w = epi::cvtpk(p[b + 6], p[b + 7]); return __builtin_bit_cast(bf16x8, w); }
__device__ __forceinline__ float xhalf_max(float v) { auto rr = __builtin_amdgcn_permlane32_swap(__float_as_uint(v), __float_as_uint(v), false, false); return fmaxf(__uint_as_float(rr[0]), __uint_as_float(rr[1])); }
__device__ __forceinline__ float xhalf_sum(float v) { auto rr = __builtin_amdgcn_permlane32_swap(__float_as_uint(v), __float_as_uint(v), false, false); return __uint_as_float(rr[0]) + __uint_as_float(rr[1]); }

__device__ __forceinline__ void attn_unit(LAS unsigned char* lds, int b, int h, int qb, const bf16* Q, const bf16* KN, const bf16* KPE, const bf16* V, bf16* AO) {
    const int tid = threadIdx.x, lane = tid & 63, r32 = lane & 31, hi = lane >> 5; const int wid = __builtin_amdgcn_readfirstlane(tid >> 6);
    const size_t rowbase = (size_t)b * SEQ; const int q0 = qb * 256;
    const unsigned lds0 = (unsigned)(uintptr_t)lds;
    const bf16* ksrc0 = KN + (rowbase + lane) * 2048 + h * 128 + wid * 8;
    const bf16* ksrc2 = KPE + (rowbase + lane) * 64 + wid * 8;
    const bf16* vsrc0 = V + (rowbase + 16 * (wid & 3) + (lane >> 2)) * 2048 + h * 128 + 32 * (wid >> 2) + (lane & 3) * 8;
    const unsigned kd = lds0 + (unsigned)wid * 1024u;
#define ATT_DMA_TILE(t, so) do { const size_t ko_ = (size_t)(t) * 64 * 2048, po_ = (size_t)(t) * 64 * 64; const unsigned d_ = (unsigned)__builtin_amdgcn_readfirstlane(kd + (so)); \
        glds16(ksrc0 + ko_, d_); glds16(ksrc0 + ko_ + 64, d_ + 8192u); glds16(ksrc2 + po_, d_ + 16384u); \
        glds16(vsrc0 + ko_, d_ + KSLOT); glds16(vsrc0 + ko_ + 64, d_ + KSLOT + 8192u); } while (0)
    const int NT = 4 * (qb + 1);
    ATT_DMA_TILE(0, 0);
    const bf16* Qw = Q + (rowbase + q0 + wid * 32 + r32) * 3072 + h * DQK + hi * 8;
    bf16x8 qr[12];
#pragma unroll
    for (int ks = 0; ks < 12; ++ks) qr[ks] = *(const bf16x8*)(Qw + ks * 16);
#pragma unroll
    for (int ks = 0; ks < 12; ++ks) asm volatile("" : "+v"(qr[ks]));
    float mrow = -1e30f, lsum = 0.f; f32x16 oT[4];
#pragma unroll
    for (int d = 0; d < 4; ++d)
#pragma unroll
        for (int r = 0; r < 16; ++r) oT[d][r] = 0.f;
    const int qrel = wid * 32 + r32;
    for (int t = 0; t < NT; ++t) {
        const int so = (t & 1) * SLOT;
        asm volatile("s_waitcnt vmcnt(0) lgkmcnt(0)\n\ts_barrier" ::: "memory");
        if (t + 1 < NT) ATT_DMA_TILE(t + 1, ((t + 1) & 1) * SLOT);
        const int jb = t - 4 * qb;
        if (!(jb >= 0 && 64 * jb > 32 * wid + 31)) {
            f32x16 p0, p1;
#pragma unroll
            for (int r = 0; r < 16; ++r) { p0[r] = 0.f; p1[r] = 0.f; }
            const LAS char* kb = (const LAS char*)lds + so + hi * 1024 + r32 * 16;
#pragma unroll
            for (int ks = 0; ks < 12; ++ks) { const bf16x8 a0 = *(const LAS bf16x8*)(kb + ks * 2048), a1 = *(const LAS bf16x8*)(kb + ks * 2048 + 512);
                p0 = __builtin_amdgcn_mfma_f32_32x32x16_bf16(a0, qr[ks], p0, 0, 0, 0); p1 = __builtin_amdgcn_mfma_f32_32x32x16_bf16(a1, qr[ks], p1, 0, 0, 0); }
            if (jb >= 0) { const int kb0 = 64 * jb + 4 * hi; const float NEG = -__builtin_inff();
#pragma unroll
                for (int r = 0; r < 16; ++r) { const int kv = kb0 + (r & 3) + 8 * (r >> 2); if (kv > qrel) p0[r] = NEG; if (kv + 32 > qrel) p1[r] = NEG; } }
            float mx = fmaxf(p0[0], p1[0]);
#pragma unroll
            for (int r = 1; r < 16; ++r) mx = fmaxf(mx, fmaxf(p0[r], p1[r]));
            mx = xhalf_max(mx);
            const float mnew = fmaxf(mrow, mx), alpha = __builtin_amdgcn_exp2f(mrow - mnew); mrow = mnew;
            float ps = 0.f;
#pragma unroll
            for (int r = 0; r < 16; ++r) { p0[r] = __builtin_amdgcn_exp2f(p0[r] - mnew); p1[r] = __builtin_amdgcn_exp2f(p1[r] - mnew); ps += p0[r] + p1[r]; }
            lsum = lsum * alpha + ps;
            if (!__all(alpha == 1.0f)) {
#pragma unroll
                for (int d = 0; d < 4; ++d)
#pragma unroll
                    for (int r = 0; r < 16; ++r) oT[d][r] *= alpha; }
            const bf16x8 pb0 = pack8(p0, 0), pb1 = pack8(p0, 8), pb2 = pack8(p1, 0), pb3 = pack8(p1, 8);
            const LAS char* vb = (const LAS char*)lds + so + KSLOT + ((lane >> 4) & 1) * 32 + (lane & 3) * 8 + (4 * hi + ((lane & 15) >> 2)) * 64;
#pragma unroll
            for (int d = 0; d < 4; ++d) {
#define ATT_PV(s, PB) do { const s16x4 lo_ = vtr(vb + d * 4096 + (s) * 1024), hi_ = vtr(vb + d * 4096 + (s) * 1024 + 512); \
                const bf16x8 vf_ = (bf16x8){lo_[0], lo_[1], lo_[2], lo_[3], hi_[0], hi_[1], hi_[2], hi_[3]}; oT[d] = __builtin_amdgcn_mfma_f32_32x32x16_bf16(vf_, PB, oT[d], 0, 0, 0); } while (0)
                ATT_PV(0, pb0); ATT_PV(1, pb1); ATT_PV(2, pb2); ATT_PV(3, pb3);
#undef ATT_PV
            }
        }
    }
    const float inv = 1.0f / xhalf_sum(lsum);
    bf16* Ow = AO + (rowbase + q0 + wid * 32 + r32) * 2048 + h * 128 + 4 * hi;
#pragma unroll
    for (int d = 0; d < 4; ++d)
#pragma unroll
        for (int g = 0; g < 4; ++g) { f32x4 v = {oT[d][4 * g] * inv, oT[d][4 * g + 1] * inv, oT[d][4 * g + 2] * inv, oT[d][4 * g + 3] * inv};
            *(pg8::u32x2*)(Ow + 32 * d + 8 * g) = epi::pack4(v); }
#undef ATT_DMA_TILE
}
}

#define XB_TMO      128
#define XB_XCNT(j)  (256  + 64 * (j))
#define XB_XSUB(j)  (1280 + 64 * (j))
#define XB_XGEN(j)  (2304 + 64 * (j))
#define XB_TOP      3328
#define XB_TOPGEN   3392
#define XCD_BAR_WORDS 3456
#define XB_SPIN_CAP (1u << 18)
__device__ __forceinline__ unsigned xb_ld(unsigned* p)              { return __hip_atomic_load(p, __ATOMIC_RELAXED, __HIP_MEMORY_SCOPE_AGENT); }
__device__ __forceinline__ unsigned xb_add(unsigned* p, unsigned v) { return __hip_atomic_fetch_add(p, v, __ATOMIC_RELAXED, __HIP_MEMORY_SCOPE_AGENT); }
__device__ __forceinline__ unsigned xb_xcc_id() { return (unsigned)__builtin_amdgcn_s_getreg((3 << 11) | 20) & 0xFu; }
#define XB_SPIN(cond, bar) do { unsigned _sp = 0; while (cond) { __builtin_amdgcn_s_sleep(1); \
    if ((++_sp & 255u) == 0u) { if (xb_ld(&(bar)[XB_TMO])) break; if (_sp > XB_SPIN_CAP) { atomicAdd(&(bar)[XB_TMO], 1u); break; } } } } while (0)
struct XcdBarrier { unsigned* bar; unsigned x; volatile LAS unsigned* st; };
__device__ __forceinline__ XcdBarrier xcd_barrier_post(unsigned* bar, volatile LAS unsigned* st) {
    XcdBarrier b; b.bar = bar; b.x = xb_xcc_id(); b.st = st;
    if (threadIdx.x == 0) (void)xb_add(&bar[XB_XCNT(b.x)], 1u);
    return b;
}
__device__ __forceinline__ void xcd_barrier_complete(unsigned* bar, unsigned x, unsigned& nloc, unsigned& nx) {
    const unsigned G = gridDim.x * gridDim.y * gridDim.z;
    unsigned sum, cnt, mine, sp = 0u;
    for (;;) {
        sum = 0u; cnt = 0u; mine = 0u;
#pragma unroll
        for (unsigned j = 0; j < 16; ++j) { const unsigned c = xb_ld(&bar[XB_XCNT(j)]); sum += c; cnt += (c > 0u) ? 1u : 0u; mine = (j == x) ? c : mine; }
        if (sum == G) break;
        __builtin_amdgcn_s_sleep(1);
        if ((++sp & 255u) == 0u) { if (xb_ld(&bar[XB_TMO])) break; if (sp > XB_SPIN_CAP) { atomicAdd(&bar[XB_TMO], 1u); break; } }
    }
    nloc = mine > 0u ? mine : 1u; nx = cnt > 0u ? cnt : 1u;
}
__device__ __forceinline__ void xcd_barrier(const XcdBarrier& b) {
    asm volatile("s_waitcnt vmcnt(0)" ::: "memory");
    __syncthreads();
    if (threadIdx.x == 0) {
        unsigned* bar = b.bar;
        __builtin_amdgcn_s_waitcnt(0);
        unsigned nloc = b.st[0], nx = b.st[1];
        if (nloc == 0u) { xcd_barrier_complete(bar, b.x, nloc, nx); b.st[0] = nloc; b.st[1] = nx; }
        const unsigned old = xb_add(&bar[XB_XSUB(b.x)], 1u);
        const unsigned gen = old / nloc;
        if (old + 1u == (gen + 1u) * nloc) {
            __builtin_amdgcn_fence(__ATOMIC_RELEASE, "agent");
            asm volatile("s_waitcnt vmcnt(0)" ::: "memory");
            const unsigned og = xb_add(&bar[XB_TOP], 1u);
            const unsigned tg = og / nx;
            if (og + 1u == (tg + 1u) * nx) xb_add(&bar[XB_TOPGEN], 1u);
            else XB_SPIN(xb_ld(&bar[XB_TOPGEN]) == tg, bar);
            __builtin_amdgcn_fence(__ATOMIC_ACQUIRE, "agent");
            xb_add(&bar[XB_XGEN(b.x)], 1u);
            asm volatile("s_waitcnt vmcnt(0)" ::: "memory");
        } else {
            XB_SPIN(xb_ld(&bar[XB_XGEN(b.x)]) == gen, bar);
            __builtin_amdgcn_fence(__ATOMIC_ACQUIRE, "agent");
            asm volatile("s_waitcnt vmcnt(0)" ::: "memory");
        }
    }
    __syncthreads();
}

constexpr int NWAVES = 8;
constexpr int RING_OFF = 0, RING_BYTES = 131072;
constexpr int LDSCTL_OFF = RING_BYTES, MISC_OFF = LDSCTL_OFF + 320;
constexpr int LDS_BYTES = 147456;
constexpr int CW_BAR = 4096;
static_assert((CW_BAR + XCD_BAR_WORDS) * 4 <= (int)CTL_ZERO_BYTES, "barrier words inside the memset region");
static_assert(att::LDS_BYTES <= RING_BYTES && sgu::LDS_BYTES <= RING_BYTES && NWAVES * 64 * 33 * 4 <= RING_BYTES, "phase scratch fits the ring");
#define LDS_WAIT() asm volatile("s_waitcnt lgkmcnt(0)" ::: "memory")
#define WG_DRAIN_BAR() asm volatile("s_waitcnt vmcnt(0) lgkmcnt(0)\n\ts_barrier" ::: "memory")

__device__ __forceinline__ int pairpos(int p) { const int i = p & 31; return 8 * (i >> 2) + (i & 3) + ((p >> 5) << 2); }
template <int MAP> __device__ __forceinline__ int dest_row(int n) {
    if constexpr (MAP == 1) { return n < 1024 ? n : (n < 1088 ? 7168 + pairpos(n - 1024) : n - 64); }
    else if constexpr (MAP == 2) { const int h = n / DQK, d = n - h * DQK; return d < 128 ? h * 128 + d : 2048 + h * 64 + pairpos(d - 128); }
    else if constexpr (MAP == 3) { return (n >> 7) * 256 + (n & 127); }
    else if constexpr (MAP == 4) { return (n >> 7) * 256 + 128 + (n & 127); }
    else return n;
}
template <int MAP> __device__ __forceinline__ void cvt_tile(const float* W, int ldw, int K, int nblk, const float* ksc, bf16* WT, int row_off, LAS unsigned* scr, int item, int lane) {
    const int kb = item / nblk, nb = item - kb * nblk, k0 = 64 * kb, n0 = 64 * nb, q = lane & 15, r = lane >> 4;
    const float* src = W + (size_t)(k0 + 2 * r) * ldw + n0 + 4 * q;
    pg8::f32x4 v[16];
#pragma unroll
    for (int i = 0; i < 16; ++i) v[i] = *(const pg8::f32x4*)(src + (size_t)(8 * (i >> 1) + (i & 1)) * ldw);
    if (ksc) {
#pragma unroll
        for (int j = 0; j < 8; ++j) { const pg8::f32x2 sc = *(const pg8::f32x2*)(ksc + k0 + 8 * j + 2 * r); v[2 * j] = v[2 * j] * sc[0]; v[2 * j + 1] = v[2 * j + 1] * sc[1]; } }
#pragma unroll
    for (int j = 0; j < 8; ++j)
#pragma unroll
        for (int e = 0; e < 4; ++e) scr[(4 * j + r) * 65 + 4 * q + e] = epi::cvtpk(v[2 * j][e], v[2 * j + 1][e]);
    LDS_WAIT(); asm volatile("" ::: "memory");
    const int c = lane & 7;
#pragma unroll
    for (int t = 0; t < 8; ++t) { const int n = (lane >> 3) + 8 * t; const LAS unsigned* s = scr + (4 * c) * 65 + n;
        pg8::u32x4 o; o.x = s[0]; o.y = s[65]; o.z = s[130]; o.w = s[195];
        *(pg8::u32x4*)(WT + (size_t)(row_off + dest_row<MAP>(n0 + n)) * K + k0 + 8 * c) = o; }
    LDS_WAIT(); asm volatile("" ::: "memory");
}

struct Args { const void* in[20]; float* out; unsigned char* ws; int ph_lo, ph_hi; };

__global__ void __launch_bounds__(NWAVES * 64, 2) mega_fwd(Args args) {
    extern __shared__ __attribute__((aligned(16))) unsigned char lds_raw[];
    LAS unsigned char* lds = (LAS unsigned char*)lds_raw;
    volatile LAS unsigned* MISC = (volatile LAS unsigned*)(lds + MISC_OFF);
    const int tid = threadIdx.x, lane = tid & 63, wave = __builtin_amdgcn_readfirstlane(tid >> 6);
    const int G = gridDim.x, bx = blockIdx.x, vcu = (G % 8 == 0) ? (bx % 8) * (G / 8) + bx / 8 : bx;
    const int gw = vcu * NWAVES + wave, NGW = G * NWAVES;
    unsigned char* ws = args.ws;
    const float* x = (const float*)args.in[0]; const int* pos = (const int*)args.in[1]; const float* g_mix = (const float*)args.in[2]; const float* w_in = (const float*)args.in[3];
    const float* b_gate = (const float*)args.in[4]; const float* g_q = (const float*)args.in[5]; const float* w_uq = (const float*)args.in[6]; const float* g_kv = (const float*)args.in[7];
    const float* w_ukv = (const float*)args.in[8]; const float* w_oa = (const float*)args.in[9]; const float* g_sgu = (const float*)args.in[10]; const float* w_sgu = (const float*)args.in[11];
    const float* b_sgu = (const float*)args.in[12]; const float* w_os = (const float*)args.in[13]; const float* w_out = (const float*)args.in[14]; const float* g_ffn = (const float*)args.in[15];
    const float* w_g = (const float*)args.in[16]; const float* w_u = (const float*)args.in[17]; const float* w_d = (const float*)args.in[18]; const float* g_fin = (const float*)args.in[19];
    float* COS = (float*)(ws + WS_COS); float* SIN = (float*)(ws + WS_SIN);
    float* QSS = (float*)(ws + WS_QSS); float* KVSS = (float*)(ws + WS_KVSS); float* VSS = (float*)(ws + WS_VSS); float* H1SS = (float*)(ws + WS_H1SS); float* H2SS = (float*)(ws + WS_H2SS);
    bf16* Win_t = (bf16*)(ws + WS_WIN); bf16* Wqkv_t = (bf16*)(ws + WS_WQKV); bf16* Wosgu_t = (bf16*)(ws + WS_WOSGU); bf16* Woatt_t = (bf16*)(ws + WS_WOATT); bf16* Wout_t = (bf16*)(ws + WS_WOUT);
    bf16* Wgu_t = (bf16*)args.out; bf16* Wdown_t = (bf16*)(ws + WS_WDOWN);
    bf16* XN = (bf16*)(ws + WS_XN); bf16* AO = (bf16*)(ws + WS_AO); bf16* U = (bf16*)(ws + WS_U); bf16* GV = (bf16*)(ws + WS_GV); bf16* YS = (bf16*)(ws + WS_YS);
    bf16* QKVL = (bf16*)(ws + WS_QKVL); bf16* KPE = (bf16*)(ws + WS_KPE); bf16* SG = (bf16*)(ws + WS_SG); bf16* Q = (bf16*)(ws + WS_Q);
    bf16* KN = (bf16*)(ws + WS_KN); bf16* V = (bf16*)(ws + WS_V); bf16* MG = (bf16*)(ws + WS_MG); float* H1 = (float*)(ws + WS_H1); bf16* H1B = (bf16*)(ws + WS_H1B);
    bf16* ACT = (bf16*)(ws + WS_ACT); bf16* Gt = (bf16*)args.out;

    for (int u = tid; u < (LDS_BYTES - LDSCTL_OFF) / 4; u += NWAVES * 64) ((LAS unsigned*)(lds + LDSCTL_OFF))[u] = 0u;
    __syncthreads();
    const int lo = args.ph_lo, hi = args.ph_hi;
    XcdBarrier bar; bar.bar = (unsigned*)(ws + WS_CTL) + CW_BAR; bar.x = 0; bar.st = nullptr;
    if (hi - lo > 1) bar = xcd_barrier_post((unsigned*)(ws + WS_CTL) + CW_BAR, MISC + 8);
#ifndef REPS
#define REPS {1,1,1,1,1,1,1,1,1}
#endif
#ifndef XBARS
#define XBARS 0
#endif
    constexpr int reps[9] = REPS;
#define IN(k) (lo <= (k) && (k) < hi)
#define SEAM(k) do { if (IN(k) && IN((k) + 1)) xcd_barrier(bar); } while (0)

    if (IN(0)) for (int rep_ = 0; rep_ < reps[0]; ++rep_) {
        LAS unsigned* scr = (LAS unsigned*)(lds + RING_OFF + wave * 16384);
        constexpr int I_IN = (DM / 64) * (DIN / 64), I_UQ = (QLR / 64) * (3072 / 64), I_UKV = (KVLR / 64) * (4096 / 64), I_OS = (SGW / 64) * (DM / 64), I_OA = (DM / 64) * (DM / 64), I_OUT = I_OA;
        constexpr int NITEMS = I_IN + I_UQ + I_UKV + I_OS + I_OA + I_OUT;
        for (int it = gw; it < NITEMS; it += NGW) {
            int r = it;
            if (r < I_IN) { cvt_tile<1>(w_in, DIN, DM, DIN / 64, nullptr, Win_t, 0, scr, r, lane); continue; } r -= I_IN;
            if (r < I_UQ) { cvt_tile<2>(w_uq, 3072, QLR, 3072 / 64, g_q, Wqkv_t, 0, scr, r, lane); continue; } r -= I_UQ;
            if (r < I_UKV) { cvt_tile<0>(w_ukv, 4096, KVLR, 4096 / 64, g_kv, Wqkv_t, 3072, scr, r, lane); continue; } r -= I_UKV;
            if (r < I_OS) { cvt_tile<0>(w_os, DM, SGW, DM / 64, nullptr, Wosgu_t, 0, scr, r, lane); continue; } r -= I_OS;
            if (r < I_OA) { cvt_tile<0>(w_oa, DM, DM, DM / 64, nullptr, Woatt_t, 0, scr, r, lane); continue; } r -= I_OA;
            cvt_tile<0>(w_out, DM, DM, DM / 64, nullptr, Wout_t, 0, scr, r, lane);
        }
        { pg8::u32x4* pad = (pg8::u32x4*)(Win_t + (size_t)DIN * DM); const int npad = (NIN_T - DIN) * DM * 2 / 16;
          for (int i = vcu * 512 + tid; i < npad; i += G * 512) pad[i] = (pg8::u32x4){0u, 0u, 0u, 0u}; }
        for (int idx = vcu * 512 + tid; idx < M * 32; idx += G * 512) { const int m = idx >> 5, i = idx & 31;
            const float inv = powf(10000.0f, -(float)(2 * i) / 64.0f); const float ang = (float)pos[m] * inv; COS[idx] = cosf(ang); SIN[idx] = sinf(ang); }
        for (int m = gw; m < M; m += NGW) {
            const pg8::f32x4* xr = (const pg8::f32x4*)(x + (size_t)m * DM) + lane; pg8::f32x4 v[8]; float s = 0.f;
#pragma unroll
            for (int j = 0; j < 8; ++j) { v[j] = xr[64 * j]; s += epi::sq4(v[j]); }
            const float r = 1.0f / sqrtf(wave_sum(s) * (1.0f / DM) + EPS);
            pg8::u32x2* o8 = (pg8::u32x2*)(XN + (size_t)m * DM) + lane;
#pragma unroll
            for (int j = 0; j < 8; ++j) { const pg8::f32x4 gg = *((const pg8::f32x4*)g_mix + lane + 64 * j); o8[64 * j] = epi::pack4(v[j] * r * gg); }
        }
    }
    SEAM(0);
    if (IN(1)) for (int rep_ = 0; rep_ < reps[1]; ++rep_) {
        pg8::Gemm g{XN, Win_t, DM, DM, DM}; pg8::StaticOrder S; S.init(M, NIN_T, G, bx);
        epi::EpiP1 E{QKVL, U, GV, Gt, KPE, QSS, KVSS, VSS, b_gate, COS, SIN};
        pg8::gemm_phase<epi::EpiP1, pg8::StaticOrder, true, true>(lds + RING_OFF, g, S, E);
    }
    SEAM(1);
    if (IN(2)) for (int rep_ = 0; rep_ < reps[2]; ++rep_) {
        pg8::Gemm g{QKVL, Wqkv_t, 1024, 512, 512}; pg8::StaticOrder S; S.init(M, 7168, G, bx, 12, 512);
        epi::EpiP2 E{Q, KN, V, QSS, KVSS, COS, SIN};
        pg8::gemm_phase<epi::EpiP2, pg8::StaticOrder, true, true>(lds + RING_OFF, g, S, E);
        for (int u = vcu; u < BATCH * (SEQ / CHUNK) * SGG; u += G) sgu::sgu_unit(lds + RING_OFF, u, U, GV, VSS, g_sgu, w_sgu, b_sgu, SG);
    }
    SEAM(2);
    if (IN(3)) for (int rep_ = 0; rep_ < reps[3]; ++rep_) {
        for (int p = vcu; p < BATCH * NH * 4; p += G) { const int bh = p >> 2, s = p & 3;
            att::attn_unit(lds + RING_OFF, bh / NH, bh % NH, s, Q, KN, KPE, V, AO);
            att::attn_unit(lds + RING_OFF, bh / NH, bh % NH, 7 - s, Q, KN, KPE, V, AO); }
        WG_DRAIN_BAR();
        pg8::Gemm g{SG, Wosgu_t, SGW, SGW, SGW}; pg8::StaticOrder S; S.init(M, DM, G, bx);
        epi::EpiYs E{YS, Gt};
        pg8::gemm_phase<epi::EpiYs, pg8::StaticOrder, false, true>(lds + RING_OFF, g, S, E);
    }
    SEAM(3);
    if (IN(4)) for (int rep_ = 0; rep_ < reps[4]; ++rep_) {
        pg8::Gemm g{AO, Woatt_t, DM, DM, DM}; pg8::StaticOrder S; S.init(M, DM, G, bx);
        epi::EpiMg E{MG, Gt, YS};
        pg8::gemm_phase<epi::EpiMg, pg8::StaticOrder, false, true>(lds + RING_OFF, g, S, E);
    }
    SEAM(4);
    if (IN(5)) for (int rep_ = 0; rep_ < reps[5]; ++rep_) {
        LAS unsigned* scr = (LAS unsigned*)(lds + RING_OFF + wave * 16384);
        constexpr int I_G = (DM / 64) * (DFF / 64), I_D = (DFF / 64) * (DM / 64), NITEMS = 2 * I_G + I_D;
        for (int it = gw; it < NITEMS; it += NGW) {
            int r = it;
            if (r < I_G) { cvt_tile<3>(w_g, DFF, DM, DFF / 64, g_ffn, Wgu_t, 0, scr, r, lane); continue; } r -= I_G;
            if (r < I_G) { cvt_tile<4>(w_u, DFF, DM, DFF / 64, g_ffn, Wgu_t, 0, scr, r, lane); continue; } r -= I_G;
            cvt_tile<0>(w_d, DM, DFF, DM / 64, nullptr, Wdown_t, 0, scr, r, lane);
        }
        WG_DRAIN_BAR();
        pg8::Gemm g{MG, Wout_t, DM, DM, DM}; pg8::StaticOrder S; S.init(M, DM, G, bx);
        epi::EpiH1 E{x, H1, H1B, H1SS};
        pg8::gemm_phase<epi::EpiH1, pg8::StaticOrder, false, true>(lds + RING_OFF, g, S, E);
    }
    SEAM(5);
    if (IN(6)) for (int rep_ = 0; rep_ < reps[6]; ++rep_) {
        pg8::Gemm g{H1B, Wgu_t, DM, DM, DM}; pg8::StaticOrder S; S.init(M, 2 * DFF, G, bx);
        epi::EpiAct E{ACT, H1SS};
        pg8::gemm_phase<epi::EpiAct, pg8::StaticOrder, true, true>(lds + RING_OFF, g, S, E);
    }
    SEAM(6);
    if (IN(7)) for (int rep_ = 0; rep_ < reps[7]; ++rep_) {
        pg8::Gemm g{ACT, Wdown_t, DFF, DFF, DFF}; pg8::StaticOrder S; S.init(M, DM, G, bx);
        epi::EpiH2 E{H1, args.out, H2SS};
        pg8::gemm_phase<epi::EpiH2, pg8::StaticOrder, false, true>(lds + RING_OFF, g, S, E);
    }
    SEAM(7);
    if (IN(7) && IN(8)) for (int xb_ = 0; xb_ < XBARS; ++xb_) xcd_barrier(bar);
    if (IN(8)) for (int rep_ = 0; rep_ < reps[8]; ++rep_) {
        for (int m = gw; m < M; m += NGW) {
            float s = (lane < 32) ? H2SS[(size_t)m * 32 + lane] : 0.f; s = wave_sum(s);
            const float r = 1.0f / sqrtf(s * (1.0f / DM) + EPS);
            pg8::f32x4* o = (pg8::f32x4*)(args.out + (size_t)m * DM) + lane; pg8::f32x4 hv[8];
#pragma unroll
            for (int j = 0; j < 8; ++j) hv[j] = o[64 * j];
#pragma unroll
            for (int j = 0; j < 8; ++j) o[64 * j] = hv[j] * r * *((const pg8::f32x4*)g_fin + lane + 64 * j);
        }
    }
#undef IN
#undef SEAM
}

#ifndef OPTMASK
#define OPTMASK 0x1ff
#endif
template <int NC, class F> static void run_ngemm(hipStream_t st, const bf16* A, int lda, int K, int N, int ldw, const float* ks, F f) {
    hipLaunchKernelGGL((ngemm<NC, F>), dim3((N + 255) / 256, M / 16), dim3(256), 0, st, A, lda, K, N, ldw, ks, f);
}
extern "C" void kernel_launch(void* const* d_in, const int* in_sizes, int n_in, void* d_out, int out_size, void* d_ws, size_t ws_size, hipStream_t stream) {
    static int grid = 0;
    if (grid == 0) {
        if (n_in != 20 || ws_size < WS_END || out_size != M * DM || in_sizes[0] != M * DM) { fprintf(stderr, "kernel_launch: unexpected shapes (n_in %d ws %zu out %d)\n", n_in, ws_size, out_size); grid = -1; return; }
        int dev = 0, cus = 0, per_cu = 0;
        if (hipGetDevice(&dev) != hipSuccess || hipDeviceGetAttribute(&cus, hipDeviceAttributeMultiprocessorCount, dev) != hipSuccess) { grid = -1; return; }
        if (hipFuncSetAttribute((const void*)mega_fwd, hipFuncAttributeMaxDynamicSharedMemorySize, LDS_BYTES) != hipSuccess) { fprintf(stderr, "kernel_launch: hipFuncSetAttribute failed\n"); grid = -1; return; }
        if (hipOccupancyMaxActiveBlocksPerMultiprocessor(&per_cu, (const void*)mega_fwd, NWAVES * 64, LDS_BYTES) != hipSuccess || per_cu < 1) { fprintf(stderr, "kernel_launch: occupancy query says %d blocks per CU\n", per_cu); per_cu = 1; }
        (void)hipGetLastError();
        grid = cus;
        if (grid != 256) fprintf(stderr, "kernel_launch: %d CUs (tuned for 256)\n", grid);
    }
    if (grid < 0) return;
    const float* x = (const float*)d_in[0]; const int* pos = (const int*)d_in[1]; const float* g_mix = (const float*)d_in[2]; const float* w_in = (const float*)d_in[3];
    const float* b_gate = (const float*)d_in[4]; const float* g_q = (const float*)d_in[5]; const float* w_uq = (const float*)d_in[6]; const float* g_kv = (const float*)d_in[7];
    const float* w_ukv = (const float*)d_in[8]; const float* w_oa = (const float*)d_in[9]; const float* g_sgu = (const float*)d_in[10]; const float* w_sgu = (const float*)d_in[11];
    const float* b_sgu = (const float*)d_in[12]; const float* w_os = (const float*)d_in[13]; const float* w_out = (const float*)d_in[14]; const float* g_ffn = (const float*)d_in[15];
    const float* w_g = (const float*)d_in[16]; const float* w_u = (const float*)d_in[17]; const float* w_d = (const float*)d_in[18]; const float* g_fin = (const float*)d_in[19];
    unsigned char* ws = (unsigned char*)d_ws; float* out = (float*)d_out;
    float* COS = (float*)(ws + WS_COS); float* SIN = (float*)(ws + WS_SIN);
    float* RQ = (float*)(ws + WS_RQ); float* RKV = (float*)(ws + WS_RKV); float* RV = (float*)(ws + WS_RV); float* RF = (float*)(ws + WS_RF);
    bf16* XN = (bf16*)(ws + WS_XN); bf16* AO = (bf16*)(ws + WS_AO); bf16* U = (bf16*)(ws + WS_U); bf16* GV = (bf16*)(ws + WS_GV); bf16* YS = (bf16*)(ws + WS_YS);
    bf16* QKVL = (bf16*)(ws + WS_QKVL); bf16* KPE = (bf16*)(ws + WS_KPE); bf16* SG = (bf16*)(ws + WS_SG); bf16* Q = (bf16*)(ws + WS_Q);
    bf16* KN = (bf16*)(ws + WS_KN); bf16* V = (bf16*)(ws + WS_V); bf16* MG = (bf16*)(ws + WS_MG); float* H1 = (float*)(ws + WS_H1); bf16* H1B = (bf16*)(ws + WS_H1B);
    bf16* ACT = (bf16*)(ws + WS_ACT); bf16* G = (bf16*)d_out;
    (void)hipMemsetAsync(ws + WS_CTL, 0, CTL_ZERO_BYTES, stream);
    Args a{};
    for (int i = 0; i < 20; ++i) a.in[i] = d_in[i];
    a.out = out; a.ws = ws;
#if defined(PRE_PHASE)
    for (int i = 0; i < PRE_COUNT; ++i) { a.ph_lo = PRE_PHASE; a.ph_hi = PRE_PHASE + 1; hipLaunchKernelGGL(mega_fwd, dim3(grid), dim3(NWAVES * 64), LDS_BYTES, stream, a); }
#endif
    for (int p = 0; p < 9;) {
        if ((OPTMASK >> p) & 1) { int q = p; while (q < 9 && ((OPTMASK >> q) & 1)) ++q;
            a.ph_lo = p; a.ph_hi = q; hipLaunchKernelGGL(mega_fwd, dim3(grid), dim3(NWAVES * 64), LDS_BYTES, stream, a);
            const hipError_t le = hipPeekAtLastError(); if (le != hipSuccess) fprintf(stderr, "kernel_launch: launch [%d,%d) failed: %s\n", p, q, hipGetErrorName(le));
            p = q; continue; }
        switch (p) {
        case 0: hipLaunchKernelGGL(k_rope_tab, dim3(M * 32 / 256), dim3(256), 0, stream, pos, COS, SIN);
                hipLaunchKernelGGL(k_rmsnorm_x, dim3(M / 4), dim3(256), 0, stream, x, g_mix, XN); break;
        case 1: run_ngemm<1>(stream, XN, DM, DM, 1024, DIN, nullptr, FStore{w_in, QKVL, 1024});
                run_ngemm<2>(stream, XN, DM, DM, 32, DIN, nullptr, FKpe{w_in, KPE, COS, SIN});
                run_ngemm<1>(stream, XN, DM, DM, 1024, DIN, nullptr, FGelu{w_in + O3, U, 1024});
                run_ngemm<1>(stream, XN, DM, DM, 1024, DIN, nullptr, FGelu{w_in + O3 + 1024, GV, 1024});
                run_ngemm<1>(stream, XN, DM, DM, 4096, DIN, nullptr, FGate{w_in + O4, G, b_gate}); break;
        case 2: hipLaunchKernelGGL((k_rowscale<bf16>), dim3(M / 4), dim3(256), 0, stream, (const bf16*)QKVL, 1024, 512, RQ);
                hipLaunchKernelGGL((k_rowscale<bf16>), dim3(M / 4), dim3(256), 0, stream, (const bf16*)QKVL + 512, 1024, 512, RKV);
                hipLaunchKernelGGL((k_rowscale<bf16>), dim3(M / 4), dim3(256), 0, stream, (const bf16*)GV, 1024, 1024, RV);
                run_ngemm<1>(stream, QKVL, 1024, 512, 2048, 3072, g_q, FQnope{w_uq, Q, RQ});
                run_ngemm<2>(stream, QKVL, 1024, 512, 512, 3072, g_q, FQpe{w_uq, Q, RQ, COS, SIN});
                run_ngemm<1>(stream, QKVL + 512, 1024, 512, 4096, 4096, g_kv, FKV{w_ukv, KN, V, RKV});
                hipLaunchKernelGGL(k_sgu_naive, dim3(M * SGW / 256), dim3(256), 0, stream, (const bf16*)U, (const bf16*)GV, (const float*)RV, g_sgu, w_sgu, b_sgu, SG); break;
        case 3: hipLaunchKernelGGL(k_attn_naive, dim3(BATCH * NH * SEQ), dim3(128), 0, stream, (const bf16*)Q, (const bf16*)KN, (const bf16*)KPE, (const bf16*)V, AO);
                run_ngemm<1>(stream, SG, 1024, 1024, 2048, 2048, nullptr, FYs{w_os, YS, G}); break;
        case 4: run_ngemm<1>(stream, AO, 2048, 2048, 2048, 2048, nullptr, FMg{w_oa, MG, G, YS}); break;
        case 5: run_ngemm<1>(stream, MG, 2048, 2048, 2048, 2048, nullptr, FH1{w_out, x, H1, H1B}); break;
        case 6: hipLaunchKernelGGL((k_rowscale<float>), dim3(M / 4), dim3(256), 0, stream, (const float*)H1, 2048, 2048, RF);
                run_ngemm<2>(stream, H1B, 2048, 2048, DFF, DFF, g_ffn, FAct{w_g, w_u, ACT, RF}); break;
        case 7: run_ngemm<1>(stream, ACT, DFF, DFF, 2048, 2048, nullptr, FH2{w_d, H1}); break;
        default: hipLaunchKernelGGL(k_final_norm, dim3(M / 4), dim3(256), 0, stream, (const float*)H1, g_fin, out); break;
        }
        ++p;
    }
}
```

```cpp
#include <hip/hip_runtime.h>
#include <cstdio>
#include <cstdint>

typedef unsigned short bf16;
constexpr int BATCH = 4, SEQ = 2048, DM = 2048, M = BATCH * SEQ;
constexpr int NH = 16, DNOPE = 128, DROPE = 64, DV = 128, DQK = 192, QLR = 512, KVLR = 512;
constexpr int SGW = 1024, SGG = 8, SGD = 128, CHUNK = 128;
constexpr int DFF = 5632, DIN = 7232;
constexpr int O1 = 512, O2 = 1024, O3 = 1088, O4 = 3136;
constexpr float EPS = 1e-6f;
constexpr float QSCALE = 0.07216878364870322f * 1.4426950408889634f;
constexpr int NIN_T = 7424;

constexpr size_t MiB = 1u << 20;
constexpr size_t WS_CTL = 0, CTL_ZERO_BYTES = 64 * 1024;
constexpr size_t WS_COS = 1 * MiB, WS_SIN = 2 * MiB;
constexpr size_t WS_QSS = 3 * MiB, WS_KVSS = WS_QSS + 256 * 1024, WS_VSS = WS_KVSS + 256 * 1024;
constexpr size_t WS_H1SS = 4 * MiB, WS_H2SS = 5 * MiB;
constexpr size_t WS_RQ = 6 * MiB, WS_RKV = WS_RQ + 32768, WS_RV = WS_RKV + 32768, WS_RF = WS_RV + 32768, WS_RO = WS_RF + 32768;
constexpr size_t WS_WGU = 8 * MiB, WS_WDOWN = 52 * MiB;
constexpr size_t WS_KPE = 74 * MiB, WS_WOSGU = 75 * MiB, WS_WOATT = 79 * MiB, WS_WOUT = 87 * MiB;
constexpr size_t WS_WQKV = 95 * MiB;
constexpr size_t WS_QKVL = 102 * MiB, WS_U = 118 * MiB, WS_GV = 134 * MiB;
constexpr size_t WS_WIN = 150 * MiB, WS_XN = 179 * MiB;
constexpr size_t WS_Q = 178 * MiB, WS_KN = 226 * MiB, WS_V = 258 * MiB, WS_SG = 290 * MiB;
constexpr size_t WS_AO = 95 * MiB, WS_YS = 127 * MiB;
constexpr size_t WS_MG = 178 * MiB;
constexpr size_t WS_H1 = 210 * MiB, WS_H1B = 274 * MiB;
constexpr size_t WS_ACT = 74 * MiB;
constexpr size_t WS_END = 306 * MiB;

__device__ __forceinline__ float bf2f(bf16 v) { return __uint_as_float((unsigned)v << 16); }
__device__ __forceinline__ bf16 f2bf(float f) { unsigned u = __float_as_uint(f); return (bf16)((u + 0x7fffu + ((u >> 16) & 1u)) >> 16); }
__device__ __forceinline__ float rbf(float f) { return bf2f(f2bf(f)); }
__device__ __forceinline__ float sigmoidf_(float x) { return __builtin_amdgcn_rcpf(1.f + __builtin_amdgcn_exp2f(-x * 1.4426950408889634f)); }
__device__ __forceinline__ float gelu_tanh(float x) { const float y = 0.7978845608028654f * (x + 0.044715f * x * x * x); return x * sigmoidf_(2.f * y); }
__device__ __forceinline__ float wave_sum(float v) {
#pragma unroll
    for (int o = 1; o < 64; o <<= 1) v += __shfl_xor(v, o);
    return v;
}
__global__ void __launch_bounds__(256) k_rope_tab(const int* __restrict__ pos, float* __restrict__ COS, float* __restrict__ SIN) {
    const int idx = blockIdx.x * 256 + threadIdx.x; if (idx >= M * 32) return;
    const int m = idx >> 5, i = idx & 31;
    const float inv = powf(10000.0f, -(float)(2 * i) / 64.0f);
    const float ang = (float)pos[m] * inv;
    COS[idx] = cosf(ang); SIN[idx] = sinf(ang);
}
__global__ void __launch_bounds__(256) k_rmsnorm_x(const float* __restrict__ x, const float* __restrict__ g, bf16* __restrict__ XN) {
    const int lane = threadIdx.x & 63, row = blockIdx.x * 4 + (threadIdx.x >> 6);
    const float* xr = x + (size_t)row * DM; float s = 0.f;
    for (int c = lane; c < DM; c += 64) { const float v = xr[c]; s += v * v; }
    const float r = 1.0f / sqrtf(wave_sum(s) * (1.0f / DM) + EPS);
    for (int c = lane; c < DM; c += 64) XN[(size_t)row * DM + c] = f2bf(xr[c] * r * g[c]);
}
template <class T> __global__ void __launch_bounds__(256) k_rowscale(const T* __restrict__ X, int ld, int K, float* __restrict__ r) {
    const int lane = threadIdx.x & 63, row = blockIdx.x * 4 + (threadIdx.x >> 6);
    float s = 0.f;
    for (int c = lane; c < K; c += 64) { float v; if constexpr (sizeof(T) == 2) v = bf2f(X[(size_t)row * ld + c]); else v = X[(size_t)row * ld + c]; s += v * v; }
    s = wave_sum(s);
    if (lane == 0) r[row] = 1.0f / sqrtf(s / (float)K + EPS);
}
template <int NC, class F>
__global__ void __launch_bounds__(256) ngemm(const bf16* __restrict__ A, int lda, int K, int N, int ldw, const float* __restrict__ kscale, F f) {
    const int n = blockIdx.x * 256 + threadIdx.x; const int m0 = blockIdx.y * 16;
    if (n >= N) return;
    const float* wp[NC];
#pragma unroll
    for (int j = 0; j < NC; ++j) wp[j] = f.col(n, j);
    float acc[NC][16];
#pragma unroll
    for (int j = 0; j < NC; ++j)
#pragma unroll
        for (int r = 0; r < 16; ++r) acc[j][r] = 0.f;
    for (int k = 0; k < K; k += 8) {
        float w[NC][8];
#pragma unroll
        for (int j = 0; j < NC; ++j)
#pragma unroll
            for (int e = 0; e < 8; ++e) w[j][e] = rbf(wp[j][(size_t)(k + e) * ldw] * (kscale ? kscale[k + e] : 1.f));
#pragma unroll
        for (int r = 0; r < 16; ++r) {
            const uint4 a = *(const uint4*)(A + (size_t)(m0 + r) * lda + k);
            const float av[8] = {__uint_as_float(a.x << 16), __uint_as_float(a.x & 0xffff0000u), __uint_as_float(a.y << 16), __uint_as_float(a.y & 0xffff0000u),
                                 __uint_as_float(a.z << 16), __uint_as_float(a.z & 0xffff0000u), __uint_as_float(a.w << 16), __uint_as_float(a.w & 0xffff0000u)};
#pragma unroll
            for (int j = 0; j < NC; ++j)
#pragma unroll
                for (int e = 0; e < 8; ++e) acc[j][r] += av[e] * w[j][e];
        }
    }
#pragma unroll
    for (int r = 0; r < 16; ++r) { float v[NC];
#pragma unroll
        for (int j = 0; j < NC; ++j) v[j] = acc[j][r];
        f.store(m0 + r, n, v); }
}
struct FStore { const float* W; bf16* O; int ldo; int pad;
    __device__ const float* col(int n, int) const { return W + n; }
    __device__ void store(int m, int n, const float (&v)[1]) const { O[(size_t)m * ldo + n] = f2bf(v[0]); } };
struct FGelu { const float* W; bf16* O; int ldo; int pad;
    __device__ const float* col(int n, int) const { return W + n; }
    __device__ void store(int m, int n, const float (&v)[1]) const { O[(size_t)m * ldo + n] = f2bf(gelu_tanh(v[0])); } };
struct FGate { const float* W; bf16* O; const float* b;
    __device__ const float* col(int n, int) const { return W + n; }
    __device__ void store(int m, int n, const float (&v)[1]) const { O[(size_t)m * 4096 + n] = f2bf(sigmoidf_(v[0] + b[n])); } };
struct FKpe { const float* W; bf16* O; const float* COS; const float* SIN;
    __device__ const float* col(int n, int j) const { return W + O2 + n + 32 * j; }
    __device__ void store(int m, int n, const float (&v)[2]) const { const float c = COS[m * 32 + n], s = SIN[m * 32 + n];
        O[(size_t)m * 64 + n] = f2bf(v[0] * c - v[1] * s); O[(size_t)m * 64 + 32 + n] = f2bf(v[1] * c + v[0] * s); } };
struct FQnope { const float* W; bf16* Q; const float* rq;
    __device__ const float* col(int n, int) const { return W + (n >> 7) * DQK + (n & 127); }
    __device__ void store(int m, int n, const float (&v)[1]) const { Q[(size_t)m * 3072 + (n >> 7) * DQK + (n & 127)] = f2bf(v[0] * rq[m] * QSCALE); } };
struct FQpe { const float* W; bf16* Q; const float* rq; const float* COS; const float* SIN;
    __device__ const float* col(int n, int j) const { return W + (n >> 5) * DQK + 128 + (n & 31) + 32 * j; }
    __device__ void store(int m, int n, const float (&v)[2]) const { const int h = n >> 5, i = n & 31; const float c = COS[m * 32 + i], s = SIN[m * 32 + i], sc = rq[m] * QSCALE;
        const float a = v[0] * sc, b = v[1] * sc; bf16* q = Q + (size_t)m * 3072 + h * DQK + 128;
        q[i] = f2bf(a * c - b * s); q[32 + i] = f2bf(b * c + a * s); } };
struct FKV { const float* W; bf16* KN; bf16* V; const float* rkv;
    __device__ const float* col(int n, int) const { return W + n; }
    __device__ void store(int m, int n, const float (&v)[1]) const { const int h = n >> 8, c = n & 255; const float o = v[0] * rkv[m];
        if (c < 128) KN[(size_t)m * 2048 + h * 128 + c] = f2bf(o); else V[(size_t)m * 2048 + h * 128 + (c - 128)] = f2bf(o); } };
struct FYs { const float* W; bf16* YS; const bf16* G;
    __device__ const float* col(int n, int) const { return W + n; }
    __device__ void store(int m, int n, const float (&v)[1]) const { YS[(size_t)m * 2048 + n] = f2bf(bf2f(G[(size_t)m * 4096 + 2048 + n]) * v[0]); } };
struct FMg { const float* W; bf16* MG; const bf16* G; const bf16* YS;
    __device__ const float* col(int n, int) const { return W + n; }
    __device__ void store(int m, int n, const float (&v)[1]) const { MG[(size_t)m * 2048 + n] = f2bf(bf2f(G[(size_t)m * 4096 + n]) * v[0] + bf2f(YS[(size_t)m * 2048 + n])); } };
struct FH1 { const float* W; const float* x; float* H1; bf16* H1B;
    __device__ const float* col(int n, int) const { return W + n; }
    __device__ void store(int m, int n, const float (&v)[1]) const { const float h = x[(size_t)m * 2048 + n] + v[0]; H1[(size_t)m * 2048 + n] = h; H1B[(size_t)m * 2048 + n] = f2bf(h); } };
struct FAct { const float* Wg; const float* Wu; bf16* ACT; const float* rf;
    __device__ const float* col(int n, int j) const { return (j ? Wu : Wg) + n; }
    __device__ void store(int m, int n, const float (&v)[2]) const { const float r = rf[m], g = v[0] * r, u = v[1] * r; ACT[(size_t)m * DFF + n] = f2bf(g * sigmoidf_(g) * u); } };
struct FH2 { const float* W; float* H;
    __device__ const float* col(int n, int) const { return W + n; }
    __device__ void store(int m, int n, const float (&v)[1]) const { H[(size_t)m * 2048 + n] += v[0]; } };

__global__ void __launch_bounds__(256) k_sgu_naive(const bf16* __restrict__ U, const bf16* __restrict__ GV, const float* __restrict__ rv, const float* __restrict__ gn,
                                                    const float* __restrict__ ws, const float* __restrict__ bs, bf16* __restrict__ SG) {
    const int idx = blockIdx.x * 256 + threadIdx.x; const int m = idx >> 10, c = idx & 1023, g = c >> 7, t = m & 127, mb = m - t;
    float s = 0.f;
    for (int j = 0; j <= t; ++j) s += rbf(ws[(g * CHUNK + t) * CHUNK + j]) * rbf(bf2f(GV[(size_t)(mb + j) * SGW + c]) * rv[mb + j] * gn[c]);
    SG[(size_t)m * SGW + c] = f2bf(bf2f(U[(size_t)m * SGW + c]) * (s + bs[g * CHUNK + t]));
}
__global__ void __launch_bounds__(128) k_attn_naive(const bf16* __restrict__ Q, const bf16* __restrict__ KN, const bf16* __restrict__ KPE, const bf16* __restrict__ V, bf16* __restrict__ AO) {
    __shared__ float qs[DQK]; __shared__ float sc[SEQ]; __shared__ float red[128];
    const int tid = threadIdx.x; const int q = blockIdx.x % SEQ, bh = blockIdx.x / SEQ, h = bh % NH, b = bh / NH;
    const size_t mq = (size_t)b * SEQ + q;
    for (int i = tid; i < DQK; i += 128) qs[i] = bf2f(Q[mq * 3072 + h * DQK + i]);
    __syncthreads();
    float mx = -1e30f;
    for (int j = tid; j <= q; j += 128) { const size_t mk = (size_t)b * SEQ + j; float s = 0.f;
        const bf16* kr = KN + mk * 2048 + h * 128; for (int d = 0; d < 128; ++d) s += qs[d] * bf2f(kr[d]);
        const bf16* kp = KPE + mk * 64; for (int d = 0; d < 64; ++d) s += qs[128 + d] * bf2f(kp[d]);
        sc[j] = s; mx = fmaxf(mx, s); }
    red[tid] = mx; __syncthreads();
    for (int o = 64; o > 0; o >>= 1) { if (tid < o) red[tid] = fmaxf(red[tid], red[tid + o]); __syncthreads(); }
    mx = red[0]; __syncthreads();
    float l = 0.f;
    for (int j = tid; j <= q; j += 128) { const float p = exp2f(sc[j] - mx); l += p; sc[j] = rbf(p); }
    red[tid] = l; __syncthreads();
    for (int o = 64; o > 0; o >>= 1) { if (tid < o) red[tid] += red[tid + o]; __syncthreads(); }
    l = red[0];
    float o = 0.f;
    for (int j = 0; j <= q; ++j) o += sc[j] * bf2f(V[((size_t)b * SEQ + j) * 2048 + h * 128 + tid]);
    AO[mq * 2048 + h * 128 + tid] = f2bf(o / l);
}
__global__ void __launch_bounds__(256) k_final_norm(const float* __restrict__ H, const float* __restrict__ g, float* __restrict__ out) {
    const int lane = threadIdx.x & 63, row = blockIdx.x * 4 + (threadIdx.x >> 6);
    const float* hr = H + (size_t)row * DM; float s = 0.f;
    for (int c = lane; c < DM; c += 64) { const float v = hr[c]; s += v * v; }
    const float r = 1.0f / sqrtf(wave_sum(s) * (1.0f / DM) + EPS);
    for (int c = lane; c < DM; c += 64) out[(size_t)row * DM + c] = hr[c] * r * g[c];
}


namespace pg8 {
#define PG8_LAS __attribute__((address_space(3)))
typedef unsigned short bf16_t;
typedef short bf16x8 __attribute__((ext_vector_type(8)));
typedef float f32x4 __attribute__((ext_vector_type(4)));
typedef float f32x2 __attribute__((ext_vector_type(2)));
typedef unsigned u32x4 __attribute__((ext_vector_type(4)));
typedef unsigned u32x2 __attribute__((ext_vector_type(2)));
constexpr int BM = 256, BK = 64, HALF = 128, HTB = HALF * BK * 2  , STAGE_BYTES = 8 * HTB, NXCD = 8, WGM = 8;

__host__ __device__ __forceinline__ int lds_byte(int r, int c) { const int st = (r >> 4) * 2 + (c >> 5), rr = r & 15, cc = c & 31, ob = rr * 64 + cc * 2; return st * 1024 + (ob ^ (((ob >> 9) & 1) << 5)); }
__host__ __device__ __forceinline__ void stage_rc(int b, int& R, int& C) { const int st = b / 1024, sb = b % 1024, swz = sb ^ (((sb >> 9) & 1) << 5); R = (st >> 1) * 16 + swz / 64; C = (st & 1) * 32 + (swz % 64) / 2; }
__host__ __device__ __forceinline__ int perm32(int rho) { const int n = rho >> 4, i = rho & 15; return 8 * (i >> 2) + 4 * n + (i & 3); }

struct Unit { int pm, pn, aoff; };
struct Gemm { const bf16_t* A; const bf16_t* Bt; int lda, ldb, K; };

struct StaticOrder {
    int nM, nN, nwg, G, c, split, split_aoff;
    __host__ __device__ void init(int M_, int N_, int G_, int c_, int split_ = 1 << 30, int split_aoff_ = 0) { nM = M_ / BM; nN = N_ / BM; nwg = nM * nN; G = G_; c = c_; split = split_; split_aoff = split_aoff_; }
    __host__ __device__ bool next(int i, Unit& u) const {
        const long L = (long)i * G + c; if (L >= nwg) return false;
        int wgid = (int)L; { const int q = nwg / NXCD, r = nwg % NXCD, xcd = wgid % NXCD, off = wgid / NXCD; wgid = (xcd < r ? xcd * (q + 1) : r * (q + 1) + (xcd - r) * q) + off; }
        const int nig = WGM * nN, gid = wgid / nig, fm = gid * WGM, gsz = (nM - fm) < WGM ? (nM - fm) : WGM;
        u.pm = fm + ((wgid % nig) % gsz); u.pn = (wgid % nig) / gsz; u.aoff = (u.pn >= split) ? split_aoff : 0; return true;
    }
    __device__ __forceinline__ void a_ready(const Unit&) const {}
    __device__ __forceinline__ void done(const Unit&) const {}
};
__device__ __forceinline__ unsigned cvt_pk_bf16(float lo, float hi) { unsigned r; asm volatile("v_cvt_pk_bf16_f32 %0, %1, %2" : "=v"(r) : "v"(lo), "v"(hi)); return r; }

template <class Epi, class Sched, bool ALIGN_EPI = false, bool SP2 = false>
__device__ __forceinline__ void gemm_phase(PG8_LAS unsigned char* lds, const Gemm g, const Sched& S, const Epi& E) {
    const int tid = threadIdx.x, wid = __builtin_amdgcn_readfirstlane(tid >> 6), lane = tid & 63, wr = wid >> 2, wc = wid & 3, fr = lane & 15, fq = lane >> 4;
    const int K = g.K, nt = K / BK;
    unsigned voffA[2], voffB[2];
#pragma unroll
    for (int i = 0; i < 2; ++i) { int R, C; stage_rc(tid * 16 + i * 8192, R, C); const int Rb = Epi::PERM ? ((R & ~31) + perm32(R & 31)) : R;
        voffA[i] = (unsigned)(R * g.lda + C) * 2u; voffB[i] = (unsigned)(Rb * g.ldb + C) * 2u; }
    const size_t kstep = (size_t)(BK * 2);
    const size_t hsA = (size_t)HALF * g.lda * 2, hsB = (size_t)HALF * g.ldb * 2;
    const size_t tsA = 2 * hsA, tsB = 2 * hsB;
    const unsigned ldsw = (unsigned)wid * 1024u;
    const int aoff = lds_byte(wr * 64 + fr, fq * 8), boff = lds_byte(wc * 32 + fr, fq * 8);
#define PG8_SA(b, h) (((b) * 2 + (h)) * HTB)
#define PG8_SB(b, h) ((4 + (b) * 2 + (h)) * HTB)
#define PG8_STAGE(bufoff, gbase, voff) do { _Pragma("unroll") for (int _i = 0; _i < 2; ++_i) \
        __builtin_amdgcn_global_load_lds((const unsigned*)((const char*)(gbase) + (voff)[_i]), (PG8_LAS unsigned*)(lds + (bufoff) + ldsw + _i * 8192), 16, 0, 0); } while (0)
#define PG8_LDA(dst, b, h) do { _Pragma("unroll") for (int m = 0; m < 4; ++m) _Pragma("unroll") for (int k = 0; k < 2; ++k) dst[m][k] = *(const PG8_LAS bf16x8*)(lds + PG8_SA(b, h) + aoff + m * 2048 + k * 1024); } while (0)
#define PG8_LDB(dst, b, h) do { _Pragma("unroll") for (int n = 0; n < 2; ++n) _Pragma("unroll") for (int k = 0; k < 2; ++k) dst[n][k] = *(const PG8_LAS bf16x8*)(lds + PG8_SB(b, h) + boff + n * 2048 + k * 1024); } while (0)
#define PG8_MMA(ai, bj, At, Bt) do { __builtin_amdgcn_s_setprio(1); _Pragma("unroll") for (int m = 0; m < 4; ++m) _Pragma("unroll") for (int n = 0; n < 2; ++n) _Pragma("unroll") for (int k = 0; k < 2; ++k) \
        acc[ai][bj][m][n] = __builtin_amdgcn_mfma_f32_16x16x32_bf16(Bt[n][k], At[m][k], acc[ai][bj][m][n], 0, 0, 0); __builtin_amdgcn_s_setprio(0); } while (0)
#define PG8_WAIT_V(n) asm volatile("s_waitcnt vmcnt(" #n ")" ::: "memory")
#define PG8_WAIT_L(n) asm volatile("s_waitcnt lgkmcnt(" #n ")" ::: "memory")
#define PG8_BAR __builtin_amdgcn_s_barrier()
#define PG8_SCHED __builtin_amdgcn_sched_barrier(0)
    Unit cur, nxt; int ui = 0;
    if (!S.next(0, cur)) return;
    f32x4 acc[2][2][4][2];
#pragma unroll
    for (int a = 0; a < 2; ++a)
#pragma unroll
        for (int b = 0; b < 2; ++b)
#pragma unroll
            for (int m = 0; m < 4; ++m)
#pragma unroll
                for (int n = 0; n < 2; ++n) acc[a][b][m][n] = (f32x4){0.f, 0.f, 0.f, 0.f};
    bf16x8 At[4][2], B0[2][2], B1[2][2];
    const char* cA = (const char*)g.A + (size_t)cur.pm * tsA + (size_t)cur.aoff * 2; const char* cB = (const char*)g.Bt + (size_t)cur.pn * tsB;
    S.a_ready(cur);
    if constexpr (SP2) {
        PG8_STAGE(PG8_SB(0, 0), cB, voffB); PG8_STAGE(PG8_SB(0, 1), cB + hsB, voffB); PG8_STAGE(PG8_SA(0, 0), cA, voffA); PG8_STAGE(PG8_SA(0, 1), cA + hsA, voffA);
        if (wr == 1) PG8_BAR;
        PG8_WAIT_V(2); PG8_BAR;
        PG8_STAGE(PG8_SB(1, 0), cB + kstep, voffB); PG8_STAGE(PG8_SA(1, 0), cA + kstep, voffA); PG8_STAGE(PG8_SB(1, 1), cB + hsB + kstep, voffB);
        PG8_WAIT_V(6); PG8_BAR;
    } else {
        PG8_STAGE(PG8_SB(0, 0), cB, voffB); PG8_STAGE(PG8_SA(0, 0), cA, voffA); PG8_STAGE(PG8_SB(0, 1), cB + hsB, voffB); PG8_STAGE(PG8_SA(0, 1), cA + hsA, voffA);
        if (wr == 1) PG8_BAR;
        PG8_WAIT_V(4); PG8_BAR;
        PG8_STAGE(PG8_SB(1, 0), cB + kstep, voffB); PG8_STAGE(PG8_SA(1, 0), cA + kstep, voffA); PG8_STAGE(PG8_SB(1, 1), cB + hsB + kstep, voffB);
        PG8_WAIT_V(6); PG8_BAR;
    }
    for (;;) {
        const bool has_next = S.next(ui + 1, nxt);
        const char* nA = has_next ? (const char*)g.A + (size_t)nxt.pm * tsA + (size_t)nxt.aoff * 2 : cA; const char* nB = has_next ? (const char*)g.Bt + (size_t)nxt.pn * tsB : cB;
        for (int t = 0; t < nt; t += 2) {
            const bool last = (t == nt - 2);
            const char* a1 = cA + (size_t)(t + 1) * kstep;
            const char* a2 = last ? nA : cA + (size_t)(t + 2) * kstep; const char* b2 = last ? nB : cB + (size_t)(t + 2) * kstep;
            const char* a3 = a2 + kstep; const char* b3 = b2 + kstep;
            if (last && has_next) S.a_ready(nxt);
            if constexpr (SP2) {
            PG8_LDB(B0, 0, 0); PG8_LDB(B1, 0, 1); PG8_SCHED; PG8_LDA(At, 0, 0); PG8_STAGE(PG8_SA(1, 1), a1 + hsA, voffA);
            PG8_WAIT_V(8); PG8_WAIT_L(0); PG8_BAR; PG8_MMA(0, 0, At, B0); PG8_MMA(0, 1, At, B1); PG8_BAR; PG8_SCHED;
            PG8_LDA(At, 0, 1); PG8_STAGE(PG8_SB(0, 0), b2, voffB); PG8_STAGE(PG8_SB(0, 1), b2 + hsB, voffB); PG8_STAGE(PG8_SA(0, 0), a2, voffA);
            PG8_WAIT_V(8); PG8_WAIT_L(0); PG8_BAR; PG8_MMA(1, 0, At, B0); PG8_MMA(1, 1, At, B1); PG8_BAR; PG8_SCHED;
            PG8_LDB(B0, 1, 0); PG8_LDB(B1, 1, 1); PG8_SCHED; PG8_LDA(At, 1, 0); PG8_STAGE(PG8_SA(0, 1), a2 + hsA, voffA);
            PG8_WAIT_V(8); PG8_WAIT_L(0); PG8_BAR; PG8_MMA(0, 0, At, B0); PG8_MMA(0, 1, At, B1); PG8_BAR; PG8_SCHED;
            PG8_LDA(At, 1, 1); PG8_STAGE(PG8_SB(1, 0), b3, voffB); PG8_STAGE(PG8_SB(1, 1), b3 + hsB, voffB); PG8_STAGE(PG8_SA(1, 0), a3, voffA);
            PG8_WAIT_V(8); PG8_WAIT_L(0); PG8_BAR; PG8_MMA(1, 0, At, B0); PG8_MMA(1, 1, At, B1); PG8_BAR; PG8_SCHED;
            } else {
            PG8_LDB(B0, 0, 0); PG8_SCHED; PG8_LDA(At, 0, 0); PG8_STAGE(PG8_SA(1, 1), a1 + hsA, voffA);
            PG8_WAIT_L(8); PG8_BAR; PG8_WAIT_L(0); PG8_MMA(0, 0, At, B0); PG8_BAR; PG8_SCHED;
            PG8_LDB(B1, 0, 1); PG8_STAGE(PG8_SB(0, 0), b2, voffB);
            PG8_BAR; PG8_WAIT_L(0); PG8_MMA(0, 1, At, B1); PG8_BAR;
            PG8_LDA(At, 0, 1); PG8_STAGE(PG8_SA(0, 0), a2, voffA);
            PG8_BAR; PG8_WAIT_L(0); PG8_MMA(1, 0, At, B0); PG8_BAR; PG8_SCHED;
            PG8_STAGE(PG8_SB(0, 1), b2 + hsB, voffB);
            PG8_WAIT_V(6); PG8_BAR; PG8_MMA(1, 1, At, B1); PG8_BAR;
            PG8_LDB(B0, 1, 0); PG8_SCHED; PG8_LDA(At, 1, 0); PG8_STAGE(PG8_SA(0, 1), a2 + hsA, voffA);
            PG8_WAIT_L(8); PG8_BAR; PG8_WAIT_L(0); PG8_MMA(0, 0, At, B0); PG8_BAR; PG8_SCHED;
            PG8_LDB(B1, 1, 1); PG8_STAGE(PG8_SB(1, 0), b3, voffB);
            PG8_BAR; PG8_WAIT_L(0); PG8_MMA(0, 1, At, B1); PG8_BAR;
            PG8_LDA(At, 1, 1); PG8_STAGE(PG8_SA(1, 0), a3, voffA);
            PG8_BAR; PG8_WAIT_L(0); PG8_MMA(1, 0, At, B0); PG8_BAR; PG8_SCHED;
            PG8_STAGE(PG8_SB(1, 1), b3 + hsB, voffB);
            PG8_WAIT_V(6); PG8_BAR; PG8_MMA(1, 1, At, B1); PG8_BAR;
            }
        }
        if constexpr (ALIGN_EPI) { if (wr == 0) PG8_BAR; }
        if constexpr (!Epi::AFTER_DRAIN) { E(acc, cur, wr, wc, fr, fq); S.done(cur); }
        if (!has_next) break;
#pragma unroll
        for (int a = 0; a < 2; ++a)
#pragma unroll
            for (int b = 0; b < 2; ++b)
#pragma unroll
                for (int m = 0; m < 4; ++m)
#pragma unroll
                    for (int n = 0; n < 2; ++n) acc[a][b][m][n] = (f32x4){0.f, 0.f, 0.f, 0.f};
        cur = nxt; cA = nA; cB = nB; ++ui;
        if constexpr (ALIGN_EPI) { if (wr == 1) PG8_BAR; }
    }
    PG8_WAIT_V(0);
    if constexpr (!ALIGN_EPI) { if (wr == 0) PG8_BAR; }
    PG8_BAR;
    if constexpr (Epi::AFTER_DRAIN) { E.fused(acc, cur, wr, wc, fr, fq, lds, wid, lane); S.done(cur); }
#undef PG8_SA
#undef PG8_SB
#undef PG8_STAGE
#undef PG8_LDA
#undef PG8_LDB
#undef PG8_MMA
#undef PG8_WAIT_V
#undef PG8_WAIT_L
#undef PG8_BAR
#undef PG8_SCHED
}

}

namespace epi {
using pg8::f32x4; using pg8::f32x2; using pg8::u32x4; using pg8::u32x2; using pg8::Unit;
typedef __bf16 bf16x2_t __attribute__((ext_vector_type(2)));
__device__ __forceinline__ unsigned cvtpk(float lo, float hi) { f32x2 v = {lo, hi}; bf16x2_t b = __builtin_convertvector(v, bf16x2_t); return __builtin_bit_cast(unsigned, b); }
__device__ __forceinline__ float fqsum(float s) { s += __shfl_xor(s, 16); s += __shfl_xor(s, 32); return s; }
__device__ __forceinline__ float sq4(f32x4 v) { return (v[0] * v[0] + v[1] * v[1]) + (v[2] * v[2] + v[3] * v[3]); }
__device__ __forceinline__ u32x4 pack8(f32x4 a, f32x4 b) { u32x4 w; w.x = cvtpk(a[0], a[1]); w.y = cvtpk(a[2], a[3]); w.z = cvtpk(b[0], b[1]); w.w = cvtpk(b[2], b[3]); return w; }
__device__ __forceinline__ u32x2 pack4(f32x4 a) { u32x2 w; w.x = cvtpk(a[0], a[1]); w.y = cvtpk(a[2], a[3]); return w; }
__device__ __forceinline__ void unpack8(u32x4 w, f32x4& a, f32x4& b) {
    a[0] = __uint_as_float(w.x << 16); a[1] = __uint_as_float(w.x & 0xffff0000u); a[2] = __uint_as_float(w.y << 16); a[3] = __uint_as_float(w.y & 0xffff0000u);
    b[0] = __uint_as_float(w.z << 16); b[1] = __uint_as_float(w.z & 0xffff0000u); b[2] = __uint_as_float(w.w << 16); b[3] = __uint_as_float(w.w & 0xffff0000u); }
__device__ __forceinline__ f32x4 gelu4(f32x4 v) { f32x4 o; o[0] = gelu_tanh(v[0]); o[1] = gelu_tanh(v[1]); o[2] = gelu_tanh(v[2]); o[3] = gelu_tanh(v[3]); return o; }
__device__ __forceinline__ f32x4 sigm4(f32x4 v) { f32x4 o; o[0] = sigmoidf_(v[0]); o[1] = sigmoidf_(v[1]); o[2] = sigmoidf_(v[2]); o[3] = sigmoidf_(v[3]); return o; }
template <int NSLOT> __device__ __forceinline__ void row_scales(const float* SS, int row0, int fq, float inv_n, float (&rs)[2][4]) {
#pragma unroll
    for (int ai = 0; ai < 2; ++ai)
#pragma unroll
        for (int m = 0; m < 4; ++m) { const float* p = SS + (size_t)(row0 + ai * 128 + m * 16) * NSLOT + fq * (NSLOT / 4); float s;
            if constexpr (NSLOT == 8) { const f32x2 v = *(const f32x2*)p; s = v[0] + v[1]; }
            else if constexpr (NSLOT == 16) { const f32x4 v = *(const f32x4*)p; s = (v[0] + v[1]) + (v[2] + v[3]); }
            else { const f32x4 v = *(const f32x4*)p, w = *(const f32x4*)(p + 4); s = ((v[0] + v[1]) + (v[2] + v[3])) + ((w[0] + w[1]) + (w[2] + w[3])); }
            s = fqsum(s); rs[ai][m] = 1.0f / sqrtf(s * inv_n + EPS); }
}
#define EPI_ROWS _Pragma("unroll") for (int ai = 0; ai < 2; ++ai) _Pragma("unroll") for (int m = 0; m < 4; ++m)
#define EPI_BJ _Pragma("unroll") for (int bj = 0; bj < 2; ++bj)

struct EpiP1 {
    static constexpr bool PERM = true, AFTER_DRAIN = false;
    bf16* QKVL; bf16* U; bf16* GV; bf16* G; bf16* KPE; float* QSS; float* KVSS; float* VSS; const float* b_gate; const float* COS; const float* SIN;
    __device__ __forceinline__ void operator()(const f32x4 (&acc)[2][2][4][2], const Unit& u, int wr, int wc, int fr, int fq) const {
        const int row0 = u.pm * 256 + wr * 64 + fr, pn = u.pn, cw = wc * 32 + 8 * fq;
        if (pn < 4) {
            float* SS = (pn < 2) ? QSS : KVSS; const int slot = (pn & 1) * 4 + wc;
            EPI_ROWS { const int row = row0 + ai * 128 + m * 16; float ss = 0.f;
                EPI_BJ { const f32x4 v0 = acc[ai][bj][m][0], v1 = acc[ai][bj][m][1]; ss += sq4(v0) + sq4(v1);
                    *(u32x4*)(QKVL + (size_t)row * 1024 + pn * 256 + bj * 128 + cw) = pack8(v0, v1); }
                ss = fqsum(ss); if (fq == 0) SS[(size_t)row * 8 + slot] = ss; }
        } else if (pn < 12) {
            const bool isv = pn >= 8; bf16* O = isv ? GV : U; const int ct = (pn - (isv ? 8 : 4)) * 256;
            EPI_ROWS { const int row = row0 + ai * 128 + m * 16; float ss = 0.f;
                EPI_BJ { const f32x4 v0 = gelu4(acc[ai][bj][m][0]), v1 = gelu4(acc[ai][bj][m][1]); ss += sq4(v0) + sq4(v1);
                    *(u32x4*)(O + (size_t)row * 1024 + ct + bj * 128 + cw) = pack8(v0, v1); }
                if (isv) { ss = fqsum(ss); if (fq == 0) VSS[(size_t)row * 16 + (pn - 8) * 4 + wc] = ss; } }
        } else if (pn < 28) {
            const int ct = (pn - 12) * 256; f32x4 bv[2][2];
            EPI_BJ { bv[bj][0] = *(const f32x4*)(b_gate + ct + bj * 128 + cw); bv[bj][1] = *(const f32x4*)(b_gate + ct + bj * 128 + cw + 4); }
            EPI_ROWS { const int row = row0 + ai * 128 + m * 16;
                EPI_BJ { const f32x4 v0 = sigm4(acc[ai][bj][m][0] + bv[bj][0]), v1 = sigm4(acc[ai][bj][m][1] + bv[bj][1]);
                    *(u32x4*)(G + (size_t)row * 4096 + ct + bj * 128 + cw) = pack8(v0, v1); } }
        } else {
            if (wc < 2) { const int j4 = 4 * (4 * wc + fq);
                EPI_ROWS { const int row = row0 + ai * 128 + m * 16;
                    const f32x4 c = *(const f32x4*)(COS + (size_t)row * 32 + j4), s = *(const f32x4*)(SIN + (size_t)row * 32 + j4);
                    const f32x4 x1 = acc[ai][0][m][0], x2 = acc[ai][0][m][1];
                    *(u32x2*)(KPE + (size_t)row * 64 + j4) = pack4(x1 * c - x2 * s); *(u32x2*)(KPE + (size_t)row * 64 + 32 + j4) = pack4(x2 * c + x1 * s); } }
        }
    }
};
struct EpiP2 {
    static constexpr bool PERM = true, AFTER_DRAIN = false;
    bf16* Q; bf16* KN; bf16* V; const float* QSS; const float* KVSS; const float* COS; const float* SIN;
    __device__ __forceinline__ void operator()(const f32x4 (&acc)[2][2][4][2], const Unit& u, int wr, int wc, int fr, int fq) const {
        const int row0 = u.pm * 256 + wr * 64 + fr, pn = u.pn, cw = wc * 32 + 8 * fq;
        float rs[2][4]; row_scales<8>(pn < 12 ? QSS : KVSS, row0, fq, 1.0f / 512.0f, rs);
        if (pn < 8) {
            EPI_ROWS { const int row = row0 + ai * 128 + m * 16; const float sc = rs[ai][m] * QSCALE;
                EPI_BJ { *(u32x4*)(Q + (size_t)row * 3072 + (2 * pn + bj) * DQK + cw) = pack8(acc[ai][bj][m][0] * sc, acc[ai][bj][m][1] * sc); } }
        } else if (pn < 12) {
            EPI_ROWS { const int row = row0 + ai * 128 + m * 16; const float sc = rs[ai][m] * QSCALE;
                EPI_BJ { const int cc = bj * 128 + cw, h = 4 * (pn - 8) + (cc >> 6), j4 = (cc & 63) >> 1;
                    const f32x4 c = *(const f32x4*)(COS + (size_t)row * 32 + j4), s = *(const f32x4*)(SIN + (size_t)row * 32 + j4);
                    const f32x4 x1 = acc[ai][bj][m][0] * sc, x2 = acc[ai][bj][m][1] * sc; bf16* q = Q + (size_t)row * 3072 + h * DQK + 128 + j4;
                    *(u32x2*)q = pack4(x1 * c - x2 * s); *(u32x2*)(q + 32) = pack4(x2 * c + x1 * s); } }
        } else {
            const int h = pn - 12;
            EPI_ROWS { const int row = row0 + ai * 128 + m * 16; const float sc = rs[ai][m];
                *(u32x4*)(KN + (size_t)row * 2048 + h * 128 + cw) = pack8(acc[ai][0][m][0] * sc, acc[ai][0][m][1] * sc);
                *(u32x4*)(V + (size_t)row * 2048 + h * 128 + cw) = pack8(acc[ai][1][m][0] * sc, acc[ai][1][m][1] * sc); }
        }
    }
};
struct EpiYs {
    static constexpr bool PERM = true, AFTER_DRAIN = false;
    bf16* YS; const bf16* G;
    __device__ __forceinline__ void operator()(const f32x4 (&acc)[2][2][4][2], const Unit& u, int wr, int wc, int fr, int fq) const {
        const int row0 = u.pm * 256 + wr * 64 + fr, col0 = u.pn * 256 + wc * 32 + 8 * fq;
        EPI_ROWS { const int row = row0 + ai * 128 + m * 16;
            EPI_BJ { const int col = col0 + bj * 128; f32x4 g0, g1; unpack8(*(const u32x4*)(G + (size_t)row * 4096 + 2048 + col), g0, g1);
                *(u32x4*)(YS + (size_t)row * 2048 + col) = pack8(acc[ai][bj][m][0] * g0, acc[ai][bj][m][1] * g1); } }
    }
};
struct EpiMg {
    static constexpr bool PERM = true, AFTER_DRAIN = false;
    bf16* MG; const bf16* G; const bf16* YS;
    __device__ __forceinline__ void operator()(const f32x4 (&acc)[2][2][4][2], const Unit& u, int wr, int wc, int fr, int fq) const {
        const int row0 = u.pm * 256 + wr * 64 + fr, col0 = u.pn * 256 + wc * 32 + 8 * fq;
        EPI_ROWS { const int row = row0 + ai * 128 + m * 16;
            EPI_BJ { const int col = col0 + bj * 128; f32x4 g0, g1, y0, y1; unpack8(*(const u32x4*)(G + (size_t)row * 4096 + col), g0, g1); unpack8(*(const u32x4*)(YS + (size_t)row * 2048 + col), y0, y1);
                *(u32x4*)(MG + (size_t)row * 2048 + col) = pack8(acc[ai][bj][m][0] * g0 + y0, acc[ai][bj][m][1] * g1 + y1); } }
    }
};
struct EpiH1 {
    static constexpr bool PERM = true, AFTER_DRAIN = false;
    const float* x; float* H1; bf16* H1B; float* H1SS;
    __device__ __forceinline__ void operator()(const f32x4 (&acc)[2][2][4][2], const Unit& u, int wr, int wc, int fr, int fq) const {
        const int row0 = u.pm * 256 + wr * 64 + fr, col0 = u.pn * 256 + wc * 32 + 8 * fq;
        EPI_ROWS { const int row = row0 + ai * 128 + m * 16; float ss = 0.f;
            EPI_BJ { const size_t o = (size_t)row * 2048 + col0 + bj * 128;
                const f32x4 h0 = *(const f32x4*)(x + o) + acc[ai][bj][m][0], h1 = *(const f32x4*)(x + o + 4) + acc[ai][bj][m][1]; ss += sq4(h0) + sq4(h1);
                *(f32x4*)(H1 + o) = h0; *(f32x4*)(H1 + o + 4) = h1; *(u32x4*)(H1B + o) = pack8(h0, h1); }
            ss = fqsum(ss); if (fq == 0) H1SS[(size_t)row * 32 + u.pn * 4 + wc] = ss; }
    }
};
struct EpiAct {
    static constexpr bool PERM = true, AFTER_DRAIN = false;
    bf16* ACT; const float* H1SS;
    __device__ __forceinline__ void operator()(const f32x4 (&acc)[2][2][4][2], const Unit& u, int wr, int wc, int fr, int fq) const {
        const int row0 = u.pm * 256 + wr * 64 + fr, col0 = u.pn * 128 + wc * 32 + 8 * fq;
        float rs[2][4]; row_scales<32>(H1SS, row0, fq, 1.0f / 2048.0f, rs);
        EPI_ROWS { const int row = row0 + ai * 128 + m * 16; const float r = rs[ai][m]; f32x4 o[2];
#pragma unroll
            for (int n = 0; n < 2; ++n) { const f32x4 g = acc[ai][0][m][n] * r, up = acc[ai][1][m][n] * r; o[n] = g * sigm4(g) * up; }
            *(u32x4*)(ACT + (size_t)row * DFF + col0) = pack8(o[0], o[1]); }
    }
};
struct EpiH2 {
    static constexpr bool PERM = true, AFTER_DRAIN = false;
    const float* H; float* O; float* H2SS;
    __device__ __forceinline__ void operator()(const f32x4 (&acc)[2][2][4][2], const Unit& u, int wr, int wc, int fr, int fq) const {
        const int row0 = u.pm * 256 + wr * 64 + fr, col0 = u.pn * 256 + wc * 32 + 8 * fq;
        EPI_ROWS { const int row = row0 + ai * 128 + m * 16; float ss = 0.f;
            EPI_BJ { const size_t o = (size_t)row * 2048 + col0 + bj * 128;
                const f32x4 h0 = *(const f32x4*)(H + o) + acc[ai][bj][m][0], h1 = *(const f32x4*)(H + o + 4) + acc[ai][bj][m][1]; ss += sq4(h0) + sq4(h1);
                *(f32x4*)(O + o) = h0; *(f32x4*)(O + o + 4) = h1; }
            ss = fqsum(ss); if (fq == 0) H2SS[(size_t)row * 32 + u.pn * 4 + wc] = ss; }
    }
};
}

#define LAS __attribute__((address_space(3)))
#define GAS __attribute__((address_space(1)))
namespace sgu {
using pg8::f32x4; using pg8::u32x4; using pg8::u32x2; using pg8::bf16x8;
constexpr int TP = 136;
constexpr int LDS_T = 0, LDS_W = 128 * TP * 2, LDS_R = 2 * 128 * TP * 2, LDS_BYTES = LDS_R + 512;
__device__ __forceinline__ void sgu_unit(LAS unsigned char* lds, int unit, const bf16* U, const bf16* GV, const float* VSS, const float* gn, const float* ws, const float* bs, bf16* SG) {
    const int tid = threadIdx.x, lane = tid & 63, wid = __builtin_amdgcn_readfirstlane(tid >> 6), fr = lane & 15, fq = lane >> 4;
    const int g = unit & 7, m0 = (unit >> 3) * 128, c0 = g * 128;
    LAS bf16* T = (LAS bf16*)(lds + LDS_T); LAS bf16* WSL = (LAS bf16*)(lds + LDS_W); LAS float* rvs = (LAS float*)(lds + LDS_R);
    if (tid < 128) { const f32x4* p = (const f32x4*)(VSS + (size_t)(m0 + tid) * 16); float s = 0.f;
#pragma unroll
        for (int i = 0; i < 4; ++i) { const f32x4 v = p[i]; s += (v[0] + v[1]) + (v[2] + v[3]); }
        rvs[tid] = 1.0f / sqrtf(s * (1.0f / 1024.0f) + EPS); }
    __syncthreads();
#pragma unroll
    for (int i = 0; i < 4; ++i) { const int idx = tid + 512 * i, s = idx >> 4, dc = (idx & 15) * 8;
        f32x4 v0, v1; epi::unpack8(*(const u32x4*)(GV + (size_t)(m0 + s) * SGW + c0 + dc), v0, v1);
        const f32x4 g0 = *(const f32x4*)(gn + c0 + dc), g1 = *(const f32x4*)(gn + c0 + dc + 4); const float r = rvs[s];
        v0 = v0 * r * g0; v1 = v1 * r * g1;
#pragma unroll
        for (int e = 0; e < 4; ++e) { T[(dc + e) * TP + s] = f2bf(v0[e]); T[(dc + 4 + e) * TP + s] = f2bf(v1[e]); } }
#pragma unroll
    for (int i = 0; i < 8; ++i) { const int idx = tid + 512 * i, t = idx >> 5, s4 = (idx & 31) * 4;
        f32x4 w = *(const f32x4*)(ws + (size_t)(g * CHUNK + t) * CHUNK + s4);
#pragma unroll
        for (int e = 0; e < 4; ++e) w[e] = (s4 + e <= t) ? w[e] : 0.f;
        *(LAS u32x2*)(WSL + t * TP + s4) = epi::pack4(w); }
    __syncthreads();
    f32x4 acc[8];
#pragma unroll
    for (int nt = 0; nt < 8; ++nt) acc[nt] = (f32x4){0.f, 0.f, 0.f, 0.f};
#pragma unroll
    for (int ks = 0; ks < 4; ++ks) {
        if (32 * ks <= 16 * wid + 15) {
            const bf16x8 bw = *(const LAS bf16x8*)(WSL + (16 * wid + fr) * TP + 32 * ks + 8 * fq);
#pragma unroll
            for (int nt = 0; nt < 8; ++nt) { const bf16x8 at = *(const LAS bf16x8*)(T + (16 * nt + fr) * TP + 32 * ks + 8 * fq);
                acc[nt] = __builtin_amdgcn_mfma_f32_16x16x32_bf16(at, bw, acc[nt], 0, 0, 0); } }
    }
    const int t = 16 * wid + fr; const float bt = bs[g * CHUNK + t]; const size_t ro = (size_t)(m0 + t) * SGW + c0 + 4 * fq;
#pragma unroll
    for (int nt = 0; nt < 8; ++nt) { const u32x2 uw = *(const u32x2*)(U + ro + 16 * nt); f32x4 uu;
        uu[0] = __uint_as_float(uw.x << 16); uu[1] = __uint_as_float(uw.x & 0xffff0000u); uu[2] = __uint_as_float(uw.y << 16); uu[3] = __uint_as_float(uw.y & 0xffff0000u);
        *(u32x2*)(SG + ro + 16 * nt) = epi::pack4(uu * (acc[nt] + bt)); }
    __syncthreads();
}
}

namespace att {
typedef short bf16x8 __attribute__((ext_vector_type(8)));
typedef short s16x4 __attribute__((ext_vector_type(4)));
typedef float f32x16 __attribute__((ext_vector_type(16)));
typedef float f32x4 __attribute__((ext_vector_type(4)));
constexpr int KSLOT = 24576, VSLOT = 16384, SLOT = KSLOT + VSLOT, NSLOT = 2, LDS_BYTES = NSLOT * SLOT;
__device__ __forceinline__ void glds16(const void* gsrc, unsigned lds_dst) { unsigned keep;
    asm volatile("s_mov_b32 %0, m0\n\ts_mov_b32 m0, %2\n\ts_nop 0\n\tglobal_load_lds_dwordx4 %1, off\n\ts_mov_b32 m0, %0" : "=&s"(keep) : "v"(gsrc), "s"(lds_dst) : "memory"); }
__device__ __forceinline__ s16x4 vtr(const LAS char* p) { typedef short v4i16_t __attribute__((ext_vector_type(4))); return __builtin_bit_cast(s16x4, __builtin_amdgcn_ds_read_tr16_b64_v4i16((LAS v4i16_t*)p)); }
__device__ __forceinline__ bf16x8 pack8(const f32x16& p, int b) { pg8::u32x4 w; w.x = epi::cvtpk(p[b], p[b + 1]); w.y = epi::cvtpk(p[b + 2], p[b + 3]); w.z = epi::cvtpk(p[b + 4], p[b + 5]); w.w = epi::cvtpk(p[b + 6], p[b + 7]); return __builtin_bit_cast(bf16x8, w); }
__device__ __forceinline__ float xhalf_max(float v) { auto rr = __builtin_amdgcn_permlane32_swap(__float_as_uint(v), __float_as_uint(v), false, false); return fmaxf(__uint_as_float(rr[0]), __uint_as_float(rr[1])); }
__device__ __forceinline__ float xhalf_sum(float v) { auto rr = __builtin_amdgcn_permlane32_swap(__float_as_uint(v), __float_as_uint(v), false, false); return __uint_as_float(rr[0]) + __uint_as_float(rr[1]); }

__device__ __forceinline__ void attn_unit(LAS unsigned char* lds, int b, int h, int qb, const bf16* Q, const bf16* KN, const bf16* KPE, const bf16* V, bf16* AO) {
    const int tid = threadIdx.x, lane = tid & 63, r32 = lane & 31, hi = lane >> 5; const int wid = __builtin_amdgcn_readfirstlane(tid >> 6);
    const size_t rowbase = (size_t)b * SEQ; const int q0 = qb * 256;
    const unsigned lds0 = (unsigned)(uintptr_t)lds;
    const bf16* ksrc0 = KN + (rowbase + lane) * 2048 + h * 128 + wid * 8;
    const bf16* ksrc2 = KPE + (rowbase + lane) * 64 + wid * 8;
    const bf16* vsrc0 = V + (rowbase + 16 * (wid & 3) + (lane >> 2)) * 2048 + h * 128 + 32 * (wid >> 2) + (lane & 3) * 8;
    const unsigned kd = lds0 + (unsigned)wid * 1024u;
#define ATT_DMA_TILE(t, so) do { const size_t ko_ = (size_t)(t) * 64 * 2048, po_ = (size_t)(t) * 64 * 64; const unsigned d_ = (unsigned)__builtin_amdgcn_readfirstlane(kd + (so)); \
        glds16(ksrc0 + ko_, d_); glds16(ksrc0 + ko_ + 64, d_ + 8192u); glds16(ksrc2 + po_, d_ + 16384u); \
        glds16(vsrc0 + ko_, d_ + KSLOT); glds16(vsrc0 + ko_ + 64, d_ + KSLOT + 8192u); } while (0)
    const int NT = 4 * (qb + 1);
    ATT_DMA_TILE(0, 0);
    const bf16* Qw = Q + (rowbase + q0 + wid * 32 + r32) * 3072 + h * DQK + hi * 8;
    bf16x8 qr[12];
#pragma unroll
    for (int ks = 0; ks < 12; ++ks) qr[ks] = *(const bf16x8*)(Qw + ks * 16);
#pragma unroll
    for (int ks = 0; ks < 12; ++ks) asm volatile("" : "+v"(qr[ks]));
    float mrow = -1e30f, lsum = 0.f; f32x16 oT[4];
#pragma unroll
    for (int d = 0; d < 4; ++d)
#pragma unroll
        for (int r = 0; r < 16; ++r) oT[d][r] = 0.f;
    const int qrel = wid * 32 + r32;
    for (int t = 0; t < NT; ++t) {
        const int so = (t & 1) * SLOT;
        asm volatile("s_waitcnt vmcnt(0) lgkmcnt(0)\n\ts_barrier" ::: "memory");
        if (t + 1 < NT) ATT_DMA_TILE(t + 1, ((t + 1) & 1) * SLOT);
        const int jb = t - 4 * qb;
        if (!(jb >= 0 && 64 * jb > 32 * wid + 31)) {
            f32x16 p0, p1;
#pragma unroll
            for (int r = 0; r < 16; ++r) { p0[r] = 0.f; p1[r] = 0.f; }
            const LAS char* kb = (const LAS char*)lds + so + hi * 1024 + r32 * 16;
#pragma unroll
            for (int ks = 0; ks < 12; ++ks) { const bf16x8 a0 = *(const LAS bf16x8*)(kb + ks * 2048), a1 = *(const LAS bf16x8*)(kb + ks * 2048 + 512);
                p0 = __builtin_amdgcn_mfma_f32_32x32x16_bf16(a0, qr[ks], p0, 0, 0, 0); p1 = __builtin_amdgcn_mfma_f32_32x32x16_bf16(a1, qr[ks], p1, 0, 0, 0); }
            if (jb >= 0) { const int kb0 = 64 * jb + 4 * hi; const float NEG = -__builtin_inff();
#pragma unroll
                for (int r = 0; r < 16; ++r) { const int kv = kb0 + (r & 3) + 8 * (r >> 2); if (kv > qrel) p0[r] = NEG; if (kv + 32 > qrel) p1[r] = NEG; } }
            float mx = fmaxf(p0[0], p1[0]);
#pragma unroll
            for (int r = 1; r < 16; ++r) mx = fmaxf(mx, fmaxf(p0[r], p1[r]));
            mx = xhalf_max(mx);
            const float mnew = fmaxf(mrow, mx), alpha = __builtin_amdgcn_exp2f(mrow - mnew); mrow = mnew;
            float ps = 0.f;
#pragma unroll
            for (int r = 0; r < 16; ++r) { p0[r] = __builtin_amdgcn_exp2f(p0[r] - mnew); p1[r] = __builtin_amdgcn_exp2f(p1[r] - mnew); ps += p0[r] + p1[r]; }
            lsum = lsum * alpha + ps;
            if (!__all(alpha == 1.0f)) {
#pragma unroll
                for (int d = 0; d < 4; ++d)
#pragma unroll
                    for (int r = 0; r < 16; ++r) oT[d][r] *= alpha; }
            const bf16x8 pb0 = pack8(p0, 0), pb1 = pack8(p0, 8), pb2 = pack8(p1, 0), pb3 = pack8(p1, 8);
            const LAS char* vb = (const LAS char*)lds + so + KSLOT + ((lane >> 4) & 1) * 32 + (lane & 3) * 8 + (4 * hi + ((lane & 15) >> 2)) * 64;
#pragma unroll
            for (int d = 0; d < 4; ++d) {
#define ATT_PV(s, PB) do { const s16x4 lo_ = vtr(vb + d * 4096 + (s) * 1024), hi_ = vtr(vb + d * 4096 + (s) * 1024 + 512); \
                const bf16x8 vf_ = (bf16x8){lo_[0], lo_[1], lo_[2], lo_[3], hi_[0], hi_[1], hi_[2], hi_[3]}; oT[d] = __builtin_amdgcn_mfma_f32_32x32x16_bf16(vf_, PB, oT[d], 0, 0, 0); } while (0)
                ATT_PV(0, pb0); ATT_PV(1, pb1); ATT_PV(2, pb2); ATT_PV(3, pb3);
#undef ATT_PV
            }
        }
    }
    const float inv = 1.0f / xhalf_sum(lsum);
    bf16* Ow = AO + (rowbase + q0 + wid * 32 + r32) * 2048 + h * 128 + 4 * hi;
#pragma unroll
    for (int d = 0; d < 4; ++d)
#pragma unroll
        for (int g = 0; g < 4; ++g) { f32x4 v = {oT[d][4 * g] * inv, oT[d][4 * g + 1] * inv, oT[d][4 * g + 2] * inv, oT[d][4 * g + 3] * inv};
            *(pg8::u32x2*)(Ow + 32 * d + 8 * g) = epi::pack4(v); }
#undef ATT_DMA_TILE
}
}

#define XB_TMO      128
#define XB_XCNT(j)  (256  + 64 * (j))
#define XB_XSUB(j)  (1280 + 64 * (j))
#define XB_XGEN(j)  (2304 + 64 * (j))
#define XB_TOP      3328
#define XB_TOPGEN   3392
#define XCD_BAR_WORDS 3456
#define XB_SPIN_CAP (1u << 18)
__device__ __forceinline__ unsigned xb_ld(unsigned* p)              { return __hip_atomic_load(p, __ATOMIC_RELAXED, __HIP_MEMORY_SCOPE_AGENT); }
__device__ __forceinline__ unsigned xb_add(unsigned* p, unsigned v) { return __hip_atomic_fetch_add(p, v, __ATOMIC_RELAXED, __HIP_MEMORY_SCOPE_AGENT); }
__device__ __forceinline__ unsigned xb_xcc_id() { return (unsigned)__builtin_amdgcn_s_getreg((3 << 11) | 20) & 0xFu; }
#define XB_SPIN(cond, bar) do { unsigned _sp = 0; while (cond) { __builtin_amdgcn_s_sleep(1); \
    if ((++_sp & 255u) == 0u) { if (xb_ld(&(bar)[XB_TMO])) break; if (_sp > XB_SPIN_CAP) { atomicAdd(&(bar)[XB_TMO], 1u); break; } } } } while (0)
struct XcdBarrier { unsigned* bar; unsigned x; volatile LAS unsigned* st; };
__device__ __forceinline__ XcdBarrier xcd_barrier_post(unsigned* bar, volatile LAS unsigned* st) {
    XcdBarrier b; b.bar = bar; b.x = xb_xcc_id(); b.st = st;
    if (threadIdx.x == 0) (void)xb_add(&bar[XB_XCNT(b.x)], 1u);
    return b;
}
__device__ __forceinline__ void xcd_barrier_complete(unsigned* bar, unsigned x, unsigned& nloc, unsigned& nx) {
    const unsigned G = gridDim.x * gridDim.y * gridDim.z;
    unsigned sum, cnt, mine, sp = 0u;
    for (;;) {
        sum = 0u; cnt = 0u; mine = 0u;
#pragma unroll
        for (unsigned j = 0; j < 16; ++j) { const unsigned c = xb_ld(&bar[XB_XCNT(j)]); sum += c; cnt += (c > 0u) ? 1u : 0u; mine = (j == x) ? c : mine; }
        if (sum == G) break;
        __builtin_amdgcn_s_sleep(1);
        if ((++sp & 255u) == 0u) { if (xb_ld(&bar[XB_TMO])) break; if (sp > XB_SPIN_CAP) { atomicAdd(&bar[XB_TMO], 1u); break; } }
    }
    nloc = mine > 0u ? mine : 1u; nx = cnt > 0u ? cnt : 1u;
}
__device__ __forceinline__ void xcd_barrier(const XcdBarrier& b) {
    asm volatile("s_waitcnt vmcnt(0)" ::: "memory");
    __syncthreads();
    if (threadIdx.x == 0) {
        unsigned* bar = b.bar;
        __builtin_amdgcn_s_waitcnt(0);
        unsigned nloc = b.st[0], nx = b.st[1];
        if (nloc == 0u) { xcd_barrier_complete(bar, b.x, nloc, nx); b.st[0] = nloc; b.st[1] = nx; }
        const unsigned old = xb_add(&bar[XB_XSUB(b.x)], 1u);
        const unsigned gen = old / nloc;
        if (old + 1u == (gen + 1u) * nloc) {
            __builtin_amdgcn_fence(__ATOMIC_RELEASE, "agent");
            asm volatile("s_waitcnt vmcnt(0)" ::: "memory");
            const unsigned og = xb_add(&bar[XB_TOP], 1u);
            const unsigned tg = og / nx;
            if (og + 1u == (tg + 1u) * nx) xb_add(&bar[XB_TOPGEN], 1u);
            else XB_SPIN(xb_ld(&bar[XB_TOPGEN]) == tg, bar);
            __builtin_amdgcn_fence(__ATOMIC_ACQUIRE, "agent");
            xb_add(&bar[XB_XGEN(b.x)], 1u);
            asm volatile("s_waitcnt vmcnt(0)" ::: "memory");
        } else {
            XB_SPIN(xb_ld(&bar[XB_XGEN(b.x)]) == gen, bar);
            __builtin_amdgcn_fence(__ATOMIC_ACQUIRE, "agent");
            asm volatile("s_waitcnt vmcnt(0)" ::: "memory");
        }
    }
    __syncthreads();
}

constexpr int NWAVES = 8;
constexpr int RING_OFF = 0, RING_BYTES = 131072;
constexpr int LDSCTL_OFF = RING_BYTES, MISC_OFF = LDSCTL_OFF + 320;
constexpr int LDS_BYTES = 147456;
constexpr int CW_BAR = 4096;
static_assert((CW_BAR + XCD_BAR_WORDS) * 4 <= (int)CTL_ZERO_BYTES, "barrier words inside the memset region");
static_assert(att::LDS_BYTES <= RING_BYTES && sgu::LDS_BYTES <= RING_BYTES && NWAVES * 64 * 33 * 4 <= RING_BYTES, "phase scratch fits the ring");
#define LDS_WAIT() asm volatile("s_waitcnt lgkmcnt(0)" ::: "memory")
#define WG_DRAIN_BAR() asm volatile("s_waitcnt vmcnt(0) lgkmcnt(0)\n\ts_barrier" ::: "memory")

__device__ __forceinline__ int pairpos(int p) { const int i = p & 31; return 8 * (i >> 2) + (i & 3) + ((p >> 5) << 2); }
template <int MAP> __device__ __forceinline__ int dest_row(int n) {
    if constexpr (MAP == 1) { return n < 1024 ? n : (n < 1088 ? 7168 + pairpos(n - 1024) : n - 64); }
    else if constexpr (MAP == 2) { const int h = n / DQK, d = n - h * DQK; return d < 128 ? h * 128 + d : 2048 + h * 64 + pairpos(d - 128); }
    else if constexpr (MAP == 3) { return (n >> 7) * 256 + (n & 127); }
    else if constexpr (MAP == 4) { return (n >> 7) * 256 + 128 + (n & 127); }
    else return n;
}
template <int MAP> __device__ __forceinline__ void cvt_tile(const float* W, int ldw, int K, int nblk, const float* ksc, bf16* WT, int row_off, LAS unsigned* scr, int item, int lane) {
    const int kb = item / nblk, nb = item - kb * nblk, k0 = 64 * kb, n0 = 64 * nb, q = lane & 15, r = lane >> 4;
    const float* src = W + (size_t)(k0 + 2 * r) * ldw + n0 + 4 * q;
    pg8::f32x4 v[16];
#pragma unroll
    for (int i = 0; i < 16; ++i) v[i] = *(const pg8::f32x4*)(src + (size_t)(8 * (i >> 1) + (i & 1)) * ldw);
    if (ksc) {
#pragma unroll
        for (int j = 0; j < 8; ++j) { const pg8::f32x2 sc = *(const pg8::f32x2*)(ksc + k0 + 8 * j + 2 * r); v[2 * j] = v[2 * j] * sc[0]; v[2 * j + 1] = v[2 * j + 1] * sc[1]; } }
#pragma unroll
    for (int j = 0; j < 8; ++j)
#pragma unroll
        for (int e = 0; e < 4; ++e) scr[(4 * j + r) * 65 + 4 * q + e] = epi::cvtpk(v[2 * j][e], v[2 * j + 1][e]);
    LDS_WAIT(); asm volatile("" ::: "memory");
    const int c = lane & 7;
#pragma unroll
    for (int t = 0; t < 8; ++t) { const int n = (lane >> 3) + 8 * t; const LAS unsigned* s = scr + (4 * c) * 65 + n;
        pg8::u32x4 o; o.x = s[0]; o.y = s[65]; o.z = s[130]; o.w = s[195];
        *(pg8::u32x4*)(WT + (size_t)(row_off + dest_row<MAP>(n0 + n)) * K + k0 + 8 * c) = o; }
    LDS_WAIT(); asm volatile("" ::: "memory");
}

struct Args { const void* in[20]; float* out; unsigned char* ws; int ph_lo, ph_hi; };

__global__ void __launch_bounds__(NWAVES * 64, 2) mega_fwd(Args args) {
    extern __shared__ __attribute__((aligned(16))) unsigned char lds_raw[];
    LAS unsigned char* lds = (LAS unsigned char*)lds_raw;
    volatile LAS unsigned* MISC = (volatile LAS unsigned*)(lds + MISC_OFF);
    const int tid = threadIdx.x, lane = tid & 63, wave = __builtin_amdgcn_readfirstlane(tid >> 6);
    const int G = gridDim.x, bx = blockIdx.x, vcu = (G % 8 == 0) ? (bx % 8) * (G / 8) + bx / 8 : bx;
    const int gw = vcu * NWAVES + wave, NGW = G * NWAVES;
    unsigned char* ws = args.ws;
    const float* x = (const float*)args.in[0]; const int* pos = (const int*)args.in[1]; const float* g_mix = (const float*)args.in[2]; const float* w_in = (const float*)args.in[3];
    const float* b_gate = (const float*)args.in[4]; const float* g_q = (const float*)args.in[5]; const float* w_uq = (const float*)args.in[6]; const float* g_kv = (const float*)args.in[7];
    const float* w_ukv = (const float*)args.in[8]; const float* w_oa = (const float*)args.in[9]; const float* g_sgu = (const float*)args.in[10]; const float* w_sgu = (const float*)args.in[11];
    const float* b_sgu = (const float*)args.in[12]; const float* w_os = (const float*)args.in[13]; const float* w_out = (const float*)args.in[14]; const float* g_ffn = (const float*)args.in[15];
    const float* w_g = (const float*)args.in[16]; const float* w_u = (const float*)args.in[17]; const float* w_d = (const float*)args.in[18]; const float* g_fin = (const float*)args.in[19];
    float* COS = (float*)(ws + WS_COS); float* SIN = (float*)(ws + WS_SIN);
    float* QSS = (float*)(ws + WS_QSS); float* KVSS = (float*)(ws + WS_KVSS); float* VSS = (float*)(ws + WS_VSS); float* H1SS = (float*)(ws + WS_H1SS); float* H2SS = (float*)(ws + WS_H2SS);
    bf16* Win_t = (bf16*)(ws + WS_WIN); bf16* Wqkv_t = (bf16*)(ws + WS_WQKV); bf16* Wosgu_t = (bf16*)(ws + WS_WOSGU); bf16* Woatt_t = (bf16*)(ws + WS_WOATT); bf16* Wout_t = (bf16*)(ws + WS_WOUT);
    bf16* Wgu_t = (bf16*)(ws + WS_WGU); bf16* Wdown_t = (bf16*)(ws + WS_WDOWN);
    bf16* XN = (bf16*)(ws + WS_XN); bf16* AO = (bf16*)(ws + WS_AO); bf16* U = (bf16*)(ws + WS_U); bf16* GV = (bf16*)(ws + WS_GV); bf16* YS = (bf16*)(ws + WS_YS);
    bf16* QKVL = (bf16*)(ws + WS_QKVL); bf16* KPE = (bf16*)(ws + WS_KPE); bf16* SG = (bf16*)(ws + WS_SG); bf16* Q = (bf16*)(ws + WS_Q);
    bf16* KN = (bf16*)(ws + WS_KN); bf16* V = (bf16*)(ws + WS_V); bf16* MG = (bf16*)(ws + WS_MG); float* H1 = (float*)(ws + WS_H1); bf16* H1B = (bf16*)(ws + WS_H1B);
    bf16* ACT = (bf16*)(ws + WS_ACT); bf16* Gt = (bf16*)args.out;

    for (int u = tid; u < (LDS_BYTES - LDSCTL_OFF) / 4; u += NWAVES * 64) ((LAS unsigned*)(lds + LDSCTL_OFF))[u] = 0u;
    __syncthreads();
    const int lo = args.ph_lo, hi = args.ph_hi;
    XcdBarrier bar; bar.bar = (unsigned*)(ws + WS_CTL) + CW_BAR; bar.x = 0; bar.st = nullptr;
    if (hi - lo > 1) bar = xcd_barrier_post((unsigned*)(ws + WS_CTL) + CW_BAR, MISC + 8);
#ifndef REPS
#define REPS {1,1,1,1,1,1,1,1,1}
#endif
#ifndef XBARS
#define XBARS 0
#endif
    constexpr int reps[9] = REPS;
#define IN(k) (lo <= (k) && (k) < hi)
#define SEAM(k) do { if (IN(k) && IN((k) + 1)) xcd_barrier(bar); } while (0)

    if (IN(0)) for (int rep_ = 0; rep_ < reps[0]; ++rep_) {
        LAS unsigned* scr = (LAS unsigned*)(lds + RING_OFF + wave * 16384);
        constexpr int I_IN = (DM / 64) * (DIN / 64);
        for (int it = gw; it < I_IN; it += NGW) cvt_tile<1>(w_in, DIN, DM, DIN / 64, nullptr, Win_t, 0, scr, it, lane);
        { pg8::u32x4* pad = (pg8::u32x4*)(Win_t + (size_t)DIN * DM); const int npad = (NIN_T - DIN) * DM * 2 / 16;
          for (int i = vcu * 512 + tid; i < npad; i += G * 512) pad[i] = (pg8::u32x4){0u, 0u, 0u, 0u}; }
        for (int idx = vcu * 512 + tid; idx < M * 32; idx += G * 512) { const int m = idx >> 5, i = idx & 31;
            const float inv = powf(10000.0f, -(float)(2 * i) / 64.0f); const float ang = (float)pos[m] * inv; COS[idx] = cosf(ang); SIN[idx] = sinf(ang); }
        for (int m = gw; m < M; m += NGW) {
            const pg8::f32x4* xr = (const pg8::f32x4*)(x + (size_t)m * DM) + lane; pg8::f32x4 v[8]; float s = 0.f;
#pragma unroll
            for (int j = 0; j < 8; ++j) { v[j] = xr[64 * j]; s += epi::sq4(v[j]); }
            const float r = 1.0f / sqrtf(wave_sum(s) * (1.0f / DM) + EPS);
            pg8::u32x2* o8 = (pg8::u32x2*)(XN + (size_t)m * DM) + lane;
#pragma unroll
            for (int j = 0; j < 8; ++j) { const pg8::f32x4 gg = *((const pg8::f32x4*)g_mix + lane + 64 * j); o8[64 * j] = epi::pack4(v[j] * r * gg); }
        }
    }
    SEAM(0);
    if (IN(1)) for (int rep_ = 0; rep_ < reps[1]; ++rep_) {
        pg8::Gemm g{XN, Win_t, DM, DM, DM}; pg8::StaticOrder S; S.init(M, NIN_T, G, bx);
        epi::EpiP1 E{QKVL, U, GV, Gt, KPE, QSS, KVSS, VSS, b_gate, COS, SIN};
        pg8::gemm_phase<epi::EpiP1, pg8::StaticOrder, true, true>(lds + RING_OFF, g, S, E);
        { const int nfull = S.nwg % G, ntail = nfull ? G - nfull : G, ti = nfull ? bx - nfull : bx;
          if (ti >= 0) { LAS unsigned* scr = (LAS unsigned*)(lds + RING_OFF + wave * 16384);
            constexpr int I_UQ = (QLR / 64) * (3072 / 64), I_UKV = (KVLR / 64) * (4096 / 64), I_G = (DM / 64) * (DFF / 64), NITEMS = I_UQ + I_UKV + 2 * I_G;
            for (int it = ti * NWAVES + wave; it < NITEMS; it += ntail * NWAVES) {
                int r = it;
                if (r < I_UQ) { cvt_tile<2>(w_uq, 3072, QLR, 3072 / 64, g_q, Wqkv_t, 0, scr, r, lane); continue; } r -= I_UQ;
                if (r < I_UKV) { cvt_tile<0>(w_ukv, 4096, KVLR, 4096 / 64, g_kv, Wqkv_t, 3072, scr, r, lane); continue; } r -= I_UKV;
                if (r < I_G) { cvt_tile<3>(w_g, DFF, DM, DFF / 64, g_ffn, Wgu_t, 0, scr, r, lane); continue; } r -= I_G;
                cvt_tile<4>(w_u, DFF, DM, DFF / 64, g_ffn, Wgu_t, 0, scr, r, lane);
            } } }
    }
    SEAM(1);
    if (IN(2)) for (int rep_ = 0; rep_ < reps[2]; ++rep_) {
        pg8::Gemm g{QKVL, Wqkv_t, 1024, 512, 512}; pg8::StaticOrder S; S.init(M, 7168, G, bx, 12, 512);
        epi::EpiP2 E{Q, KN, V, QSS, KVSS, COS, SIN};
        pg8::gemm_phase<epi::EpiP2, pg8::StaticOrder, true, true>(lds + RING_OFF, g, S, E);
        for (int u = vcu; u < BATCH * (SEQ / CHUNK) * SGG; u += G) sgu::sgu_unit(lds + RING_OFF, u, U, GV, VSS, g_sgu, w_sgu, b_sgu, SG);
        { const int nfull = S.nwg % G, ntail = nfull ? G - nfull : G, ti = nfull ? bx - nfull : bx;
          if (ti >= 0) { LAS unsigned* scr = (LAS unsigned*)(lds + RING_OFF + wave * 16384);
            constexpr int I_OS = (SGW / 64) * (DM / 64), I_OA = (DM / 64) * (DM / 64), NITEMS = I_OS + 2 * I_OA;
            for (int it = ti * NWAVES + wave; it < NITEMS; it += ntail * NWAVES) {
                int r = it;
                if (r < I_OS) { cvt_tile<0>(w_os, DM, SGW, DM / 64, nullptr, Wosgu_t, 0, scr, r, lane); continue; } r -= I_OS;
                if (r < I_OA) { cvt_tile<0>(w_oa, DM, DM, DM / 64, nullptr, Woatt_t, 0, scr, r, lane); continue; } r -= I_OA;
                cvt_tile<0>(w_out, DM, DM, DM / 64, nullptr, Wout_t, 0, scr, r, lane);
            } } }
    }
    SEAM(2);
    if (IN(3)) for (int rep_ = 0; rep_ < reps[3]; ++rep_) {
        for (int p = vcu; p < BATCH * NH * 4; p += G) { const int bh = p >> 2, s = p & 3;
            att::attn_unit(lds + RING_OFF, bh / NH, bh % NH, s, Q, KN, KPE, V, AO);
            att::attn_unit(lds + RING_OFF, bh / NH, bh % NH, 7 - s, Q, KN, KPE, V, AO); }
        WG_DRAIN_BAR();
        pg8::Gemm g{SG, Wosgu_t, SGW, SGW, SGW}; pg8::StaticOrder S; S.init(M, DM, G, bx);
        epi::EpiYs E{YS, Gt};
        pg8::gemm_phase<epi::EpiYs, pg8::StaticOrder, false, true>(lds + RING_OFF, g, S, E);
    }
    SEAM(3);
    if (IN(4)) for (int rep_ = 0; rep_ < reps[4]; ++rep_) {
        pg8::Gemm g{AO, Woatt_t, DM, DM, DM}; pg8::StaticOrder S; S.init(M, DM, G, bx);
        epi::EpiMg E{MG, Gt, YS};
        pg8::gemm_phase<epi::EpiMg, pg8::StaticOrder, false, true>(lds + RING_OFF, g, S, E);
    }
    SEAM(4);
    if (IN(5)) for (int rep_ = 0; rep_ < reps[5]; ++rep_) {
        pg8::Gemm g{MG, Wout_t, DM, DM, DM}; pg8::StaticOrder S; S.init(M, DM, G, bx);
        epi::EpiH1 E{x, H1, H1B, H1SS};
        pg8::gemm_phase<epi::EpiH1, pg8::StaticOrder, false, true>(lds + RING_OFF, g, S, E);
    }
    SEAM(5);
    if (IN(6)) for (int rep_ = 0; rep_ < reps[6]; ++rep_) {
        pg8::Gemm g{H1B, Wgu_t, DM, DM, DM}; pg8::StaticOrder S; S.init(M, 2 * DFF, G, bx);
        epi::EpiAct E{ACT, H1SS};
        pg8::gemm_phase<epi::EpiAct, pg8::StaticOrder, true, true>(lds + RING_OFF, g, S, E);
        { const int nfull = S.nwg % G, ntail = nfull ? G - nfull : G, ti = nfull ? bx - nfull : bx;
          if (ti >= 0) { LAS unsigned* scr = (LAS unsigned*)(lds + RING_OFF + wave * 16384);
            constexpr int I_D = (DFF / 64) * (DM / 64);
            for (int it = ti * NWAVES + wave; it < I_D; it += ntail * NWAVES) cvt_tile<0>(w_d, DM, DFF, DM / 64, nullptr, Wdown_t, 0, scr, it, lane);
          } }
    }
    SEAM(6);
    if (IN(7)) for (int rep_ = 0; rep_ < reps[7]; ++rep_) {
        pg8::Gemm g{ACT, Wdown_t, DFF, DFF, DFF}; pg8::StaticOrder S; S.init(M, DM, G, bx);
        epi::EpiH2 E{H1, args.out, H2SS};
        pg8::gemm_phase<epi::EpiH2, pg8::StaticOrder, false, true>(lds + RING_OFF, g, S, E);
    }
    SEAM(7);
    if (IN(7) && IN(8)) for (int xb_ = 0; xb_ < XBARS; ++xb_) xcd_barrier(bar);
    if (IN(8)) for (int rep_ = 0; rep_ < reps[8]; ++rep_) {
        for (int m = gw; m < M; m += NGW) {
            float s = (lane < 32) ? H2SS[(size_t)m * 32 + lane] : 0.f; s = wave_sum(s);
            const float r = 1.0f / sqrtf(s * (1.0f / DM) + EPS);
            pg8::f32x4* o = (pg8::f32x4*)(args.out + (size_t)m * DM) + lane; pg8::f32x4 hv[8];
#pragma unroll
            for (int j = 0; j < 8; ++j) hv[j] = o[64 * j];
#pragma unroll
            for (int j = 0; j < 8; ++j) o[64 * j] = hv[j] * r * *((const pg8::f32x4*)g_fin + lane + 64 * j);
        }
    }
#undef IN
#undef SEAM
}

#ifndef OPTMASK
#define OPTMASK 0x1ff
#endif
template <int NC, class F> static void run_ngemm(hipStream_t st, const bf16* A, int lda, int K, int N, int ldw, const float* ks, F f) {
    hipLaunchKernelGGL((ngemm<NC, F>), dim3((N + 255) / 256, M / 16), dim3(256), 0, st, A, lda, K, N, ldw, ks, f);
}
extern "C" void kernel_launch(void* const* d_in, const int* in_sizes, int n_in, void* d_out, int out_size, void* d_ws, size_t ws_size, hipStream_t stream) {
    static int grid = 0;
    if (grid == 0) {
        if (n_in != 20 || ws_size < WS_END || out_size != M * DM || in_sizes[0] != M * DM) { fprintf(stderr, "kernel_launch: unexpected shapes (n_in %d ws %zu out %d)\n", n_in, ws_size, out_size); grid = -1; return; }
        int dev = 0, cus = 0, per_cu = 0;
        if (hipGetDevice(&dev) != hipSuccess || hipDeviceGetAttribute(&cus, hipDeviceAttributeMultiprocessorCount, dev) != hipSuccess) { grid = -1; return; }
        if (hipFuncSetAttribute((const void*)mega_fwd, hipFuncAttributeMaxDynamicSharedMemorySize, LDS_BYTES) != hipSuccess) { fprintf(stderr, "kernel_launch: hipFuncSetAttribute failed\n"); grid = -1; return; }
        if (hipOccupancyMaxActiveBlocksPerMultiprocessor(&per_cu, (const void*)mega_fwd, NWAVES * 64, LDS_BYTES) != hipSuccess || per_cu < 1) { fprintf(stderr, "kernel_launch: occupancy query says %d blocks per CU\n", per_cu); per_cu = 1; }
        (void)hipGetLastError();
        grid = cus;
        if (grid != 256) fprintf(stderr, "kernel_launch: %d CUs (tuned for 256)\n", grid);
    }
    if (grid < 0) return;
    const float* x = (const float*)d_in[0]; const int* pos = (const int*)d_in[1]; const float* g_mix = (const float*)d_in[2]; const float* w_in = (const float*)d_in[3];
    const float* b_gate = (const float*)d_in[4]; const float* g_q = (const float*)d_in[5]; const float* w_uq = (const float*)d_in[6]; const float* g_kv = (const float*)d_in[7];
    const float* w_ukv = (const float*)d_in[8]; const float* w_oa = (const float*)d_in[9]; const float* g_sgu = (const float*)d_in[10]; const float* w_sgu = (const float*)d_in[11];
    const float* b_sgu = (const float*)d_in[12]; const float* w_os = (const float*)d_in[13]; const float* w_out = (const float*)d_in[14]; const float* g_ffn = (const float*)d_in[15];
    const float* w_g = (const float*)d_in[16]; const float* w_u = (const float*)d_in[17]; const float* w_d = (const float*)d_in[18]; const float* g_fin = (const float*)d_in[19];
    unsigned char* ws = (unsigned char*)d_ws; float* out = (float*)d_out;
    float* COS = (float*)(ws + WS_COS); float* SIN = (float*)(ws + WS_SIN);
    float* RQ = (float*)(ws + WS_RQ); float* RKV = (float*)(ws + WS_RKV); float* RV = (float*)(ws + WS_RV); float* RF = (float*)(ws + WS_RF);
    bf16* XN = (bf16*)(ws + WS_XN); bf16* AO = (bf16*)(ws + WS_AO); bf16* U = (bf16*)(ws + WS_U); bf16* GV = (bf16*)(ws + WS_GV); bf16* YS = (bf16*)(ws + WS_YS);
    bf16* QKVL = (bf16*)(ws + WS_QKVL); bf16* KPE = (bf16*)(ws + WS_KPE); bf16* SG = (bf16*)(ws + WS_SG); bf16* Q = (bf16*)(ws + WS_Q);
    bf16* KN = (bf16*)(ws + WS_KN); bf16* V = (bf16*)(ws + WS_V); bf16* MG = (bf16*)(ws + WS_MG); float* H1 = (float*)(ws + WS_H1); bf16* H1B = (bf16*)(ws + WS_H1B);
    bf16* ACT = (bf16*)(ws + WS_ACT); bf16* G = (bf16*)d_out;
    (void)hipMemsetAsync(ws + WS_CTL, 0, CTL_ZERO_BYTES, stream);
    Args a{};
    for (int i = 0; i < 20; ++i) a.in[i] = d_in[i];
    a.out = out; a.ws = ws;
#if defined(PRE_PHASE)
    for (int i = 0; i < PRE_COUNT; ++i) { a.ph_lo = PRE_PHASE; a.ph_hi = PRE_PHASE + 1; hipLaunchKernelGGL(mega_fwd, dim3(grid), dim3(NWAVES * 64), LDS_BYTES, stream, a); }
#endif
    for (int p = 0; p < 9;) {
        if ((OPTMASK >> p) & 1) { int q = p; while (q < 9 && ((OPTMASK >> q) & 1)) ++q;
            a.ph_lo = p; a.ph_hi = q; hipLaunchKernelGGL(mega_fwd, dim3(grid), dim3(NWAVES * 64), LDS_BYTES, stream, a);
            const hipError_t le = hipPeekAtLastError(); if (le != hipSuccess) fprintf(stderr, "kernel_launch: launch [%d,%d) failed: %s\n", p, q, hipGetErrorName(le));
            p = q; continue; }
        switch (p) {
        case 0: hipLaunchKernelGGL(k_rope_tab, dim3(M * 32 / 256), dim3(256), 0, stream, pos, COS, SIN);
                hipLaunchKernelGGL(k_rmsnorm_x, dim3(M / 4), dim3(256), 0, stream, x, g_mix, XN); break;
        case 1: run_ngemm<1>(stream, XN, DM, DM, 1024, DIN, nullptr, FStore{w_in, QKVL, 1024});
                run_ngemm<2>(stream, XN, DM, DM, 32, DIN, nullptr, FKpe{w_in, KPE, COS, SIN});
                run_ngemm<1>(stream, XN, DM, DM, 1024, DIN, nullptr, FGelu{w_in + O3, U, 1024});
                run_ngemm<1>(stream, XN, DM, DM, 1024, DIN, nullptr, FGelu{w_in + O3 + 1024, GV, 1024});
                run_ngemm<1>(stream, XN, DM, DM, 4096, DIN, nullptr, FGate{w_in + O4, G, b_gate}); break;
        case 2: hipLaunchKernelGGL((k_rowscale<bf16>), dim3(M / 4), dim3(256), 0, stream, (const bf16*)QKVL, 1024, 512, RQ);
                hipLaunchKernelGGL((k_rowscale<bf16>), dim3(M / 4), dim3(256), 0, stream, (const bf16*)QKVL + 512, 1024, 512, RKV);
                hipLaunchKernelGGL((k_rowscale<bf16>), dim3(M / 4), dim3(256), 0, stream, (const bf16*)GV, 1024, 1024, RV);
                run_ngemm<1>(stream, QKVL, 1024, 512, 2048, 3072, g_q, FQnope{w_uq, Q, RQ});
                run_ngemm<2>(stream, QKVL, 1024, 512, 512, 3072, g_q, FQpe{w_uq, Q, RQ, COS, SIN});
                run_ngemm<1>(stream, QKVL + 512, 1024, 512, 4096, 4096, g_kv, FKV{w_ukv, KN, V, RKV});
                hipLaunchKernelGGL(k_sgu_naive, dim3(M * SGW / 256), dim3(256), 0, stream, (const bf16*)U, (const bf16*)GV, (const float*)RV, g_sgu, w_sgu, b_sgu, SG); break;
        case 3: hipLaunchKernelGGL(k_attn_naive, dim3(BATCH * NH * SEQ), dim3(128), 0, stream, (const bf16*)Q, (const bf16*)KN, (const bf16*)KPE, (const bf16*)V, AO);
                run_ngemm<1>(stream, SG, 1024, 1024, 2048, 2048, nullptr, FYs{w_os, YS, G}); break;
        case 4: run_ngemm<1>(stream, AO, 2048, 2048, 2048, 2048, nullptr, FMg{w_oa, MG, G, YS}); break;
        case 5: run_ngemm<1>(stream, MG, 2048, 2048, 2048, 2048, nullptr, FH1{w_out, x, H1, H1B}); break;
        case 6: hipLaunchKernelGGL((k_rowscale<float>), dim3(M / 4), dim3(256), 0, stream, (const float*)H1, 2048, 2048, RF);
                run_ngemm<2>(stream, H1B, 2048, 2048, DFF, DFF, g_ffn, FAct{w_g, w_u, ACT, RF}); break;
        case 7: run_ngemm<1>(stream, ACT, DFF, DFF, 2048, 2048, nullptr, FH2{w_d, H1}); break;
        default: hipLaunchKernelGGL(k_final_norm, dim3(M / 4), dim3(256), 0, stream, (const float*)H1, g_fin, out); break;
        }
        ++p;
    }
}
```
